# Optimizing an MI355X kernel written in HIP

```python
import jax, jax.numpy as jnp
from jax import lax
import numpy as np

D_MODEL = 1024
BATCH = 1
SEQ = 16384
DEPTH = 2

HEAD_DIM = 64
BLK = 128
RMS_EPS = 1e-6
NEG = -1e30

A_HEADS = 8
A_KV = 2
A_GROUP = A_HEADS // A_KV
A_WINDOW = 128
B_HEADS = 8
B_KV = 2
B_GROUP = B_HEADS // B_KV
B_WINDOW = 512
L_CMP = 32
D_CMP = 16
CMP_HID = 128
L_SEL = 64
N_SEL = 16
C_HEADS = 8
MIX_W = A_HEADS * HEAD_DIM
A_KVW = A_KV * HEAD_DIM
B_KVW = B_KV * HEAD_DIM
IN_WIDTHS = (MIX_W, A_KVW, A_KVW,
             MIX_W, B_KVW, B_KVW, B_KVW, B_KVW, B_KVW, B_KVW,
             B_HEADS * 3,
             MIX_W, MIX_W, MIX_W,
             3 * D_MODEL)
D_IN = sum(IN_WIDTHS)
PEER_HEADS = 8
N_KEYS = 128
N_EXPERTS = N_KEYS * N_KEYS
PK_DIM = 128
PEER_TOPK = 16

kernel_name = "hybrid_swa_nsa_stickbreak_peer"


def rms_norm(x, g):
    xf = x.astype(jnp.float32)
    y = xf * lax.rsqrt(jnp.mean(xf * xf, axis=-1, keepdims=True) + RMS_EPS)
    return (y * g.astype(jnp.float32)).astype(x.dtype)


def alibi_slopes(n):
    return jnp.exp2(-8.0 * jnp.arange(1, n + 1, dtype=jnp.float32) / n)


def split_cols(h, widths):
    out, start = [], 0
    for w in widths:
        out.append(h[..., start:start + w])
        start += w
    return out


def unblock(o):
    o = jnp.moveaxis(o, 0, 1)
    return o.reshape((o.shape[0], o.shape[1] * o.shape[2]) + o.shape[3:])


def banded_gqa(q, k, v, window, slopes, sinks=None):
    s_len = q.shape[1]
    dh = q.shape[-1]
    nb = s_len // BLK
    pad = ((0, 0), (window, 0), (0, 0), (0, 0))
    kp, vp = jnp.pad(k, pad), jnp.pad(v, pad)
    scale = dh ** -0.5

    def block(n):
        q0 = n * BLK
        qb = lax.dynamic_slice_in_dim(q, q0, BLK, axis=1)
        kb = lax.dynamic_slice_in_dim(kp, q0, window + BLK, axis=1)
        vb = lax.dynamic_slice_in_dim(vp, q0, window + BLK, axis=1)
        t = q0 + jnp.arange(BLK)
        s = q0 - window + jnp.arange(window + BLK)
        dist = t[:, None] - s[None, :]
        mask = (s[None, :] >= 0) & (dist >= 0) & (dist < window)
        logits = (jnp.einsum('bqhgd,bkhd->bhgqk', qb, kb).astype(jnp.float32) * scale
                  - slopes[None, :, :, None, None] * dist.astype(jnp.float32))
        logits = jnp.where(mask, logits, NEG)
        if sinks is not None:
            sink = jnp.broadcast_to(sinks.astype(jnp.float32)[None, :, :, None, None],
                                    logits.shape[:-1] + (1,))
            p = jax.nn.softmax(jnp.concatenate([logits, sink], axis=-1), axis=-1)[..., :-1]
        else:
            p = jax.nn.softmax(logits, axis=-1)
        return jnp.einsum('bhgqk,bkhd->bqhgd', p.astype(vb.dtype), vb)

    return unblock(lax.map(block, jnp.arange(nb)))


def nsa_compress(kv, pos, w1, w2):
    nc = (kv.shape[1] - L_CMP) // D_CMP + 1
    idx = jnp.arange(nc)[:, None] * D_CMP + jnp.arange(L_CMP)[None, :]
    blocks = kv[:, idx] + pos[None, None, :, None, :]
    hid = jax.nn.gelu(jnp.einsum('bclhd,ldf->bchf', blocks, w1))
    return jnp.einsum('bchf,fd->bchd', hid, w2)


def nsa_compressed_selected(q, kc, vc, ks, vs, slopes):
    b, s_len, hkv, g, dh = q.shape
    nb = s_len // BLK
    nc = kc.shape[1]
    nsel = s_len // L_SEL
    n_top = min(N_SEL, nsel)
    scale = dh ** -0.5
    c_start = jnp.arange(nc) * D_CMP
    c_end = c_start + L_CMP - 1
    j_start = jnp.arange(nsel) * L_SEL
    cover = ((c_start[:, None] < j_start[None, :] + L_SEL)
             & (c_end[:, None] >= j_start[None, :])).astype(jnp.float32)
    ks_t = ks.reshape(b, nsel, L_SEL, hkv, dh).transpose(0, 3, 1, 2, 4)
    vs_t = vs.reshape(b, nsel, L_SEL, hkv, dh).transpose(0, 3, 1, 2, 4)
    bi = jnp.arange(b)[:, None, None, None]
    hi = jnp.arange(hkv)[None, None, :, None]
    j = jnp.arange(nsel)

    def block(n):
        q0 = n * BLK
        qb = lax.dynamic_slice_in_dim(q, q0, BLK, axis=1)
        t = q0 + jnp.arange(BLK)
        cvalid = c_end[None, :] <= t[:, None]
        logits = (jnp.einsum('bqhgd,bchd->bhgqc', qb, kc).astype(jnp.float32) * scale
                  - slopes[None, :, :, None, None] * (t[:, None] - c_end[None, :]).astype(jnp.float32))
        p_cmp = jnp.where(cvalid, jax.nn.softmax(jnp.where(cvalid, logits, NEG), axis=-1), 0.0)
        o_cmp = jnp.einsum('bhgqc,bchd->bqhgd', p_cmp.astype(vc.dtype), vc)
        imp = jnp.einsum('bhgqc,cj->bqhj', p_cmp, cover)
        tb = (t // L_SEL)[None, :, None, None]
        forced = (j == 0) | (j == tb) | (j == tb - 1)
        imp = jnp.where(forced, jnp.inf, jnp.where(j > tb, -jnp.inf, imp))
        _, sel = lax.top_k(imp, n_top)
        ksel = ks_t[bi, hi, sel]
        vsel = vs_t[bi, hi, sel]
        spos = sel[..., None] * L_SEL + jnp.arange(L_SEL)
        sdist = (t[None, :, None, None, None] - spos)[:, :, :, None]
        logits_s = (jnp.einsum('bqhgd,bqhnld->bqhgnl', qb, ksel).astype(jnp.float32) * scale
                    - slopes[None, None, :, :, None, None] * sdist.astype(jnp.float32))
        logits_s = jnp.where(sdist >= 0, logits_s, NEG).reshape(b, BLK, hkv, g, n_top * L_SEL)
        p_slc = jax.nn.softmax(logits_s, axis=-1).reshape(b, BLK, hkv, g, n_top, L_SEL)
        o_slc = jnp.einsum('bqhgnl,bqhnld->bqhgd', p_slc.astype(vsel.dtype), vsel)
        return o_cmp, o_slc

    o_cmp, o_slc = lax.map(block, jnp.arange(nb))
    return unblock(o_cmp), unblock(o_slc)


def stick_breaking(q, k, v):
    b, s_len, h, dh = q.shape
    nb = s_len // BLK
    scale = dh ** -0.5

    def block(n):
        q0 = n * BLK
        qb = lax.dynamic_slice_in_dim(q, q0, BLK, axis=1)
        t = q0 + jnp.arange(BLK)

        def step(i, carry):
            o, acc = carry
            k0 = (n - i) * BLK
            kb = lax.dynamic_slice_in_dim(k, k0, BLK, axis=1)
            vb = lax.dynamic_slice_in_dim(v, k0, BLK, axis=1)
            s = k0 + jnp.arange(BLK)
            valid = s[None, :] < t[:, None]
            z = jnp.einsum('bqhd,bkhd->bhqk', qb, kb).astype(jnp.float32) * scale
            log_1mb = jnp.where(valid, jax.nn.log_sigmoid(-z), 0.0)
            later = lax.cumsum(log_1mb, axis=3, reverse=True) - log_1mb
            log_a = jax.nn.log_sigmoid(z) + later + acc[..., None]
            a = jnp.where(valid, jnp.exp(log_a), 0.0)
            o = o + jnp.einsum('bhqk,bkhd->bhqd', a, vb.astype(jnp.float32))
            return o, acc + jnp.sum(log_1mb, axis=-1)

        init = (jnp.zeros((b, h, BLK, dh), jnp.float32), jnp.zeros((b, h, BLK), jnp.float32))
        o, _ = lax.fori_loop(0, n + 1, step, init)
        return jnp.swapaxes(o, 1, 2).astype(v.dtype)

    return unblock(lax.map(block, jnp.arange(nb)))


def peer(x, w_q, sub_keys, u, v):
    b, s_len, d = x.shape
    nb = s_len // BLK

    def block(n):
        xb = lax.dynamic_slice_in_dim(x, n * BLK, BLK, axis=1)
        qr = jnp.einsum('btd,dhk->bthk', xb, w_q)
        s1 = jnp.einsum('bthk,hnk->bthn', qr[..., :PK_DIM], sub_keys[0]).astype(jnp.float32)
        s2 = jnp.einsum('bthk,hnk->bthn', qr[..., PK_DIM:], sub_keys[1]).astype(jnp.float32)
        v1, i1 = lax.top_k(s1, PEER_TOPK)
        v2, i2 = lax.top_k(s2, PEER_TOPK)
        cand = (v1[..., :, None] + v2[..., None, :]).reshape(b, BLK, PEER_HEADS, PEER_TOPK * PEER_TOPK)
        sc, ci = lax.top_k(cand, PEER_TOPK)
        e = (jnp.take_along_axis(i1, ci // PEER_TOPK, axis=-1) * N_KEYS
             + jnp.take_along_axis(i2, ci % PEER_TOPK, axis=-1))
        gate = jax.nn.softmax(sc, axis=-1)
        hid = jax.nn.gelu(jnp.einsum('bthkd,btd->bthk', u[e], xb).astype(jnp.float32)) * gate
        return jnp.einsum('bthk,bthkd->btd', hid.astype(x.dtype), v[e])

    return unblock(lax.map(block, jnp.arange(nb)))


def hybrid_layer(x, norm1, w_in, sinks, cmp_pos, cmp_w1, cmp_w2, w_branch, w_out,
                 norm2, peer_wq, peer_keys, peer_u, peer_v):
    b, s_len, _ = x.shape
    h = rms_norm(x, norm1)
    (qa, ka, va, qb, kcb, vcb, ksb, vsb, kwb, vwb, gb, qc, kc, vc, gm) = split_cols(h @ w_in, IN_WIDTHS)
    heads = lambda t_, n_: t_.reshape(b, s_len, n_, HEAD_DIM)
    groups = lambda t_, n_: t_.reshape(b, s_len, n_, -1, HEAD_DIM)

    slopes_a = alibi_slopes(A_HEADS).reshape(A_KV, A_GROUP)
    o_a = banded_gqa(groups(qa, A_KV), heads(ka, A_KV), heads(va, A_KV), A_WINDOW,
                     slopes_a, sinks.reshape(A_KV, A_GROUP))

    slopes_b = alibi_slopes(B_HEADS).reshape(B_KV, B_GROUP)
    qbh = groups(qb, B_KV)
    k_cmp = nsa_compress(heads(kcb, B_KV), cmp_pos[0], cmp_w1[0], cmp_w2[0])
    v_cmp = nsa_compress(heads(vcb, B_KV), cmp_pos[1], cmp_w1[1], cmp_w2[1])
    o_cmp, o_slc = nsa_compressed_selected(qbh, k_cmp, v_cmp, heads(ksb, B_KV), heads(vsb, B_KV), slopes_b)
    o_win = banded_gqa(qbh, heads(kwb, B_KV), heads(vwb, B_KV), B_WINDOW, slopes_b)
    g_b = jax.nn.sigmoid(gb.reshape(b, s_len, B_KV, B_GROUP, 3))
    o_b = g_b[..., 0:1] * o_cmp + g_b[..., 1:2] * o_slc + g_b[..., 2:3] * o_win

    o_c = stick_breaking(heads(qc, C_HEADS), heads(kc, C_HEADS), heads(vc, C_HEADS))

    y_a = o_a.reshape(b, s_len, MIX_W) @ w_branch[0]
    y_b = o_b.reshape(b, s_len, MIX_W) @ w_branch[1]
    y_c = o_c.reshape(b, s_len, MIX_W) @ w_branch[2]
    g_m = jax.nn.sigmoid(gm.reshape(b, s_len, 3, D_MODEL))
    mixed = g_m[:, :, 0] * y_a + g_m[:, :, 1] * y_b + g_m[:, :, 2] * y_c
    x = x + mixed @ w_out

    return x + peer(rms_norm(x, norm2), peer_wq, peer_keys, peer_u, peer_v)


def setup_inputs(seed: int = 0) -> dict:
    key = jax.random.key(seed)
    ks = jax.random.split(key, 16)
    nrm = lambda k_, shape, scale: jax.random.normal(k_, shape, jnp.float32) * scale
    return {
        "x": nrm(ks[0], (BATCH, SEQ, D_MODEL), 1.0),
        "norm1": 1.0 + nrm(ks[1], (DEPTH, D_MODEL), 0.01),
        "w_in": nrm(ks[2], (DEPTH, D_MODEL, D_IN), D_MODEL ** -0.5),
        "sinks": nrm(ks[3], (DEPTH, A_HEADS), 0.5),
        "cmp_pos": nrm(ks[4], (DEPTH, 2, L_CMP, HEAD_DIM), 0.02),
        "cmp_w1": nrm(ks[5], (DEPTH, 2, L_CMP, HEAD_DIM, CMP_HID), (L_CMP * HEAD_DIM) ** -0.5),
        "cmp_w2": nrm(ks[6], (DEPTH, 2, CMP_HID, HEAD_DIM), CMP_HID ** -0.5),
        "w_branch": nrm(ks[7], (DEPTH, 3, MIX_W, D_MODEL), MIX_W ** -0.5),
        "w_out": nrm(ks[8], (DEPTH, D_MODEL, D_MODEL), D_MODEL ** -0.5),
        "norm2": 1.0 + nrm(ks[9], (DEPTH, D_MODEL), 0.01),
        "peer_wq": nrm(ks[10], (DEPTH, D_MODEL, PEER_HEADS, 2 * PK_DIM), D_MODEL ** -0.5),
        "peer_keys": nrm(ks[11], (DEPTH, 2, PEER_HEADS, N_KEYS, PK_DIM), PK_DIM ** -0.5),
        "peer_u": nrm(ks[12], (DEPTH, N_EXPERTS, D_MODEL), D_MODEL ** -0.5),
        "peer_v": nrm(ks[13], (DEPTH, N_EXPERTS, D_MODEL), PEER_HEADS ** -0.5),
        "norm_f": 1.0 + nrm(ks[14], (D_MODEL,), 0.01),
    }


def reference(x, norm1, w_in, sinks, cmp_pos, cmp_w1, cmp_w2, w_branch, w_out,
              norm2, peer_wq, peer_keys, peer_u, peer_v, norm_f):
    for l in range(DEPTH):
        x = hybrid_layer(x, norm1[l], w_in[l], sinks[l], cmp_pos[l], cmp_w1[l], cmp_w2[l],
                         w_branch[l], w_out[l], norm2[l], peer_wq[l], peer_keys[l],
                         peer_u[l], peer_v[l])
    return rms_norm(x, norm_f)
```

```cpp
#include <hip/hip_runtime.h>
#include <hip/hip_cooperative_groups.h>
#include <cstdio>
#include <cstdint>
namespace cg = cooperative_groups;

#define LAS __attribute__((address_space(3)))
typedef unsigned short bf16_t;
typedef short bf16x8 __attribute__((ext_vector_type(8)));
typedef float f32x4 __attribute__((ext_vector_type(4)));
typedef float f32x16 __attribute__((ext_vector_type(16)));
typedef unsigned u32x4 __attribute__((ext_vector_type(4)));
typedef unsigned u32x2 __attribute__((ext_vector_type(2)));

constexpr int S_LEN = 16384, DM = 1024, NLAYER = 2;
constexpr int NTHREADS = 512;
constexpr int LDS_BYTES = 144 * 1024;
constexpr int NMAIN = 5888, NVT = 1024, RW = 512, RFOOT = 3456;
constexpr int R_KCB = 0, R_VCB = 128, R_GB = 256;
constexpr int D_IN = 6680;
constexpr size_t PLANE = (size_t)S_LEN * 64;
constexpr float RMS_EPS = 1e-6f;
constexpr float LOG2E = 1.4426950408889634f;
constexpr float NEGV = -1e30f;
constexpr float U4_SCALE = 64.0f, V4_SCALE = 5.5f;

constexpr size_t OFF_BAR = 0;
constexpr size_t OFF_TICKET = OFF_BAR + 16384;
constexpr size_t OFF_ROWSS = 768 * 1024;
constexpr size_t OFF_CBIAS = 128 * 1024;
constexpr size_t OFF_KCMP = 256 * 1024;
constexpr size_t OFF_VCMP = 512 * 1024;
constexpr size_t OFF_W = 2048 * 1024;
constexpr size_t W_IN = 0;
constexpr size_t W_VT = W_IN + (size_t)NMAIN * 1024 * 2;
constexpr size_t W_BR = W_VT + (size_t)NVT * 1024 * 2;
constexpr size_t W_OUT = W_BR + (size_t)3 * 1024 * 512 * 2;
constexpr size_t W_Q = W_OUT + (size_t)1024 * 1024 * 2;
constexpr size_t W_KP = W_Q + (size_t)2048 * 1024 * 2;
constexpr size_t W_1T = W_KP + (size_t)2 * 8 * 128 * 128 * 2;
constexpr size_t W_2T = W_1T + (size_t)2 * 128 * 2048 * 2;
constexpr size_t LW = W_2T + (size_t)2 * 64 * 128 * 2;
constexpr size_t OFF_U = OFF_W + 2 * LW;
constexpr size_t OFF_V = OFF_U + (size_t)16384 * 1024 * 2;
constexpr size_t OFF_XS = OFF_V + (size_t)16384 * 1024 * 2;
constexpr size_t OFF_H = OFF_XS + (size_t)S_LEN * DM * 4;
constexpr size_t OFF_QALL = OFF_H + (size_t)S_LEN * DM * 2;
constexpr size_t OFF_KALL = OFF_QALL + 24 * PLANE * 2;
constexpr size_t OFF_VALL = OFF_KALL + 14 * PLANE * 2;
constexpr size_t OFF_R = OFF_VALL + 14 * PLANE * 2;
constexpr size_t OFF_G8 = OFF_R + (size_t)S_LEN * RW * 2;
constexpr size_t OFF_PIDS = OFF_G8 + (size_t)64 * 12 * 8 * 8 * 1024;
constexpr size_t OFF_PGT = OFF_PIDS + (size_t)S_LEN * 128 * 4;
static_assert(OFF_PGT + (size_t)S_LEN * 128 * 4 <= OFF_R + (size_t)S_LEN * RFOOT * 2, "gate / id buffers exceed the region");
constexpr size_t OFF_TEAM = OFF_BAR + 20480;
constexpr size_t OFF_RANK = OFF_BAR + 30720;
constexpr size_t OFF_OA = OFF_R + (size_t)S_LEN * RFOOT * 2;
constexpr size_t OFF_OB = OFF_OA + (size_t)S_LEN * 512 * 2;
constexpr size_t OFF_OC = OFF_OB + (size_t)S_LEN * 512 * 2;
constexpr size_t OFF_WG8 = OFF_OC + (size_t)S_LEN * 512 * 2;
constexpr size_t OFF_H8 = OFF_WG8 + (size_t)NLAYER * 3072 * 1024;
constexpr size_t OFF_WQ8 = OFF_H8 + (size_t)S_LEN * DM;
constexpr size_t WS_END = OFF_WQ8 + (size_t)NLAYER * 2048 * 1024;
constexpr float WG_SCALE = 32.0f;
constexpr float X8_SCALE = 8.0f;
static_assert(WS_END < 520u * 1024 * 1024, "workspace too large");
static_assert((LW % 256) == 0, "align");

constexpr int XB_LDS_OFF = 143360;
struct Params {
    const float* x; const float* norm1; const float* w_in; const float* sinks; const float* cmp_pos; const float* cmp_w1;
    const float* cmp_w2; const float* w_branch; const float* w_out; const float* norm2; const float* peer_wq;
    const float* peer_keys; const float* peer_u; const float* peer_v; const float* norm_f;
    float* out; unsigned char* ws;
};

__device__ __forceinline__ int opaque_bid() { int b = blockIdx.x; asm volatile("" : "+s"(b)); return b; }
__device__ __forceinline__ int opaque_tid(int wv) { unsigned z = 0u; asm volatile("" : "+s"(z));
    int t = wv * 64 + (int)__builtin_amdgcn_mbcnt_hi(~0u, __builtin_amdgcn_mbcnt_lo(~0u, z)); asm volatile("" : "+v"(t)); return t; }
typedef float f32x2_t __attribute__((ext_vector_type(2)));
typedef __bf16 bf16x2_t __attribute__((ext_vector_type(2)));
__device__ __forceinline__ unsigned cvt_pk_bf16(float lo, float hi) { const f32x2_t v = {lo, hi}; return __builtin_bit_cast(unsigned, __builtin_convertvector(v, bf16x2_t)); }
__device__ __forceinline__ float bf_lo(unsigned w) { return __uint_as_float(w << 16); }
__device__ __forceinline__ float bf_hi(unsigned w) { return __uint_as_float(w & 0xffff0000u); }
__device__ __forceinline__ float fast_exp2(float x) { return __builtin_amdgcn_exp2f(x); }
__device__ __forceinline__ float fast_exp(float x) { return __builtin_amdgcn_exp2f(x * LOG2E); }
__device__ __forceinline__ float fast_rcp(float x) { return __builtin_amdgcn_rcpf(x); }
__device__ __forceinline__ float sigmoidf_(float x) { return fast_rcp(1.0f + fast_exp(-x)); }
__device__ __forceinline__ float gelu_tanh(float x) {
    const float u = 0.7978845608028654f * (x + 0.044715f * x * x * x);
    return x * fast_rcp(1.0f + fast_exp(-2.0f * u));
}
template <int CTRL> __device__ __forceinline__ float dpp_f(float v) { return __int_as_float(__builtin_amdgcn_update_dpp(0, __float_as_int(v), CTRL, 0xf, 0xf, true)); }
template <int CTRL> __device__ __forceinline__ unsigned dpp_u(unsigned v) { return (unsigned)__builtin_amdgcn_update_dpp(0, (int)v, CTRL, 0xf, 0xf, true); }
__device__ __forceinline__ float wave_sum(float v) {
    v += dpp_f<0xB1>(v); v += dpp_f<0x4E>(v); v += dpp_f<0x141>(v); v += dpp_f<0x140>(v);
    const float a = __int_as_float(__builtin_amdgcn_readlane(__float_as_int(v), 0)), b = __int_as_float(__builtin_amdgcn_readlane(__float_as_int(v), 16));
    const float c = __int_as_float(__builtin_amdgcn_readlane(__float_as_int(v), 32)), d = __int_as_float(__builtin_amdgcn_readlane(__float_as_int(v), 48));
    return (a + b) + (c + d);
}
__device__ __forceinline__ float xor32(float v) { return __shfl_xor(v, 32); }
#define MFMA32(a, b, c) __builtin_amdgcn_mfma_f32_32x32x16_bf16((a), (b), (c), 0, 0, 0)
#define ROWOFF(r) (((r) & 3) + 8 * ((r) >> 2))
__device__ __forceinline__ bf16x8 pack8(float a0, float a1, float a2, float a3, float a4, float a5, float a6, float a7) {
    u32x4 w; w.x = cvt_pk_bf16(a0, a1); w.y = cvt_pk_bf16(a2, a3); w.z = cvt_pk_bf16(a4, a5); w.w = cvt_pk_bf16(a6, a7);
    return __builtin_bit_cast(bf16x8, w);
}
__device__ __forceinline__ f32x16 zero16() { f32x16 z;
#pragma unroll
    for (int i = 0; i < 16; ++i) z[i] = 0.f;
    return z; }
__device__ __forceinline__ unsigned f2ord(float f) { const unsigned b = __float_as_uint(f); return b ^ ((b & 0x80000000u) ? 0xffffffffu : 0x80000000u); }
__device__ __forceinline__ float ord2f(unsigned u) { const unsigned b = u ^ ((u & 0x80000000u) ? 0x80000000u : 0xffffffffu); return __uint_as_float(b); }
__device__ __forceinline__ unsigned med3u(unsigned a, unsigned b, unsigned c) { const unsigned mn = a < b ? a : b, mx = a < b ? b : a; const unsigned t = mx < c ? mx : c; return mn > t ? mn : t; }
__device__ __forceinline__ void top16_insert(unsigned (&l)[16], unsigned k) {
    unsigned n[16];
    n[0] = l[0] > k ? l[0] : k;
#pragma unroll
    for (int i = 1; i < 16; ++i) n[i] = med3u(l[i - 1], l[i], k);
#pragma unroll
    for (int i = 0; i < 16; ++i) l[i] = n[i];
    __builtin_amdgcn_sched_barrier(0);
}
#define XB_TMO      128
#define XB_XCNT(j)  (256  + 64 * (j))
#define XB_XSUB(j)  (1280 + 64 * (j))
#define XB_XGEN(j)  (2304 + 64 * (j))
#define XB_TOP      3328
#define XB_TOPGEN   3392
#define XCD_BAR_WORDS 3456
#define XB_SPIN_CAP (1u << 18)

__device__ __forceinline__ unsigned xb_ld(unsigned* p)              { return __hip_atomic_load(p, __ATOMIC_RELAXED, __HIP_MEMORY_SCOPE_AGENT); }
__device__ __forceinline__ unsigned xb_add(unsigned* p, unsigned v) { return __hip_atomic_fetch_add(p, v, __ATOMIC_RELAXED, __HIP_MEMORY_SCOPE_AGENT); }
__device__ __forceinline__ unsigned xb_xcc_id() { return (unsigned)__builtin_amdgcn_s_getreg((3 << 11) | 20) & 0xFu; }
#define XB_SPIN(cond, bar) do { unsigned _sp = 0; while (cond) { __builtin_amdgcn_s_sleep(1); \
    if ((++_sp & 255u) == 0u) { if (xb_ld(&(bar)[XB_TMO])) break; if (_sp > XB_SPIN_CAP) { atomicAdd(&(bar)[XB_TMO], 1u); break; } } } } while (0)

struct XcdBarrier {
    unsigned* bar; unsigned x;
    volatile LAS unsigned* st;
};

__device__ __forceinline__ XcdBarrier xcd_barrier_post(unsigned* bar, volatile LAS unsigned* st) {
    XcdBarrier b; b.bar = bar; b.x = xb_xcc_id(); b.st = st;
    if (threadIdx.x == 0) (void)xb_add(&bar[XB_XCNT(b.x)], 1u);
    return b;
}
__device__ __forceinline__ void xcd_barrier_complete(unsigned* bar, unsigned x, unsigned& nloc, unsigned& nx) {
    const unsigned G = gridDim.x * gridDim.y * gridDim.z;
    unsigned sum, cnt, mine, sp = 0u;
    for (;;) {
        sum = 0u; cnt = 0u; mine = 0u;
#pragma unroll
        for (unsigned j = 0; j < 16; ++j) { const unsigned c = xb_ld(&bar[XB_XCNT(j)]); sum += c; cnt += (c > 0u) ? 1u : 0u; mine = (j == x) ? c : mine; }
        if (sum == G) break;
        __builtin_amdgcn_s_sleep(1);
        if ((++sp & 255u) == 0u) { if (xb_ld(&bar[XB_TMO])) break; if (sp > XB_SPIN_CAP) { atomicAdd(&bar[XB_TMO], 1u); break; } }
    }
    nloc = mine > 0u ? mine : 1u; nx = cnt > 0u ? cnt : 1u;
}

__device__ __forceinline__ void xcd_barrier(const XcdBarrier& b) {
    asm volatile("s_waitcnt vmcnt(0)" ::: "memory");
    __syncthreads();
    if (threadIdx.x == 0) {
        unsigned* bar = b.bar;
        __builtin_amdgcn_s_waitcnt(0);
        unsigned nloc = b.st[0], nx = b.st[1];
        if (nloc == 0u) { xcd_barrier_complete(bar, b.x, nloc, nx); b.st[0] = nloc; b.st[1] = nx; }
        const unsigned old = xb_add(&bar[XB_XSUB(b.x)], 1u);
        const unsigned gen = old / nloc;
        if (old + 1u == (gen + 1u) * nloc) {
            __builtin_amdgcn_fence(__ATOMIC_RELEASE, "agent");
            asm volatile("s_waitcnt vmcnt(0)" ::: "memory");
            const unsigned og = xb_add(&bar[XB_TOP], 1u);
            const unsigned tg = og / nx;
            if (og + 1u == (tg + 1u) * nx) xb_add(&bar[XB_TOPGEN], 1u);
            else XB_SPIN(xb_ld(&bar[XB_TOPGEN]) == tg, bar);
            __builtin_amdgcn_fence(__ATOMIC_ACQUIRE, "agent");
            xb_add(&bar[XB_XGEN(b.x)], 1u);
            asm volatile("s_waitcnt vmcnt(0)" ::: "memory");
        } else {
            XB_SPIN(xb_ld(&bar[XB_XGEN(b.x)]) == gen, bar);
            __builtin_amdgcn_fence(__ATOMIC_ACQUIRE, "agent");
            asm volatile("s_waitcnt vmcnt(0)" ::: "memory");
        }
    }
    __syncthreads();
}
namespace pg8 {
#define PG8_LAS __attribute__((address_space(3)))
typedef unsigned short bf16_t;
typedef short bf16x8 __attribute__((ext_vector_type(8)));
typedef float f32x4 __attribute__((ext_vector_type(4)));
typedef unsigned u32x4 __attribute__((ext_vector_type(4)));
constexpr int BM = 256, BK = 64, HALF = 128, HTB = HALF * BK * 2  , STAGE_BYTES = 8 * HTB, NXCD = 8, WGM = 8;

__host__ __device__ __forceinline__ int lds_byte(int r, int c) { const int st = (r >> 4) * 2 + (c >> 5), rr = r & 15, cc = c & 31, ob = rr * 64 + cc * 2; return st * 1024 + (ob ^ (((ob >> 9) & 1) << 5)); }
__host__ __device__ __forceinline__ void stage_rc(int b, int& R, int& C) { const int st = b / 1024, sb = b % 1024, swz = sb ^ (((sb >> 9) & 1) << 5); R = (st >> 1) * 16 + swz / 64; C = (st & 1) * 32 + (swz % 64) / 2; }
__host__ __device__ __forceinline__ int perm32(int rho) { const int n = rho >> 4, i = rho & 15; return 8 * (i >> 2) + 4 * n + (i & 3); }

typedef int pg8_i32x4 __attribute__((ext_vector_type(4)));
struct Unit { int pm, pn; };
struct Gemm { const bf16_t* A; const bf16_t* Bt; int M, N, K; };

struct StaticOrder {
    int nM, nN, nwg, G, c, lim;
    __host__ __device__ void init(int M, int N, int G_, int c_) { nM = M / BM; nN = N / BM; nwg = nM * nN; G = G_; c = c_; lim = nwg; }
    __host__ __device__ bool next(int i, Unit& u) const {
        const long L = (long)i * G + c; if (L >= lim) return false;
        int wgid = (int)L; { const int q = nwg / NXCD, r = nwg % NXCD, xcd = wgid % NXCD, off = wgid / NXCD; wgid = (xcd < r ? xcd * (q + 1) : r * (q + 1) + (xcd - r) * q) + off; }
        const int nig = WGM * nN, gid = wgid / nig, fm = gid * WGM, gsz = (nM - fm) < WGM ? (nM - fm) : WGM;
        u.pm = fm + ((wgid % nig) % gsz); u.pn = (wgid % nig) / gsz; return true;
    }
    __device__ __forceinline__ void a_ready(const Unit&) const {}
    __device__ __forceinline__ void done(const Unit&) const {}
};
template <class Epi, class Sched, bool ALIGN_EPI = false, bool SP2 = false, bool FP8 = false>
__device__ __forceinline__ void gemm_phase(PG8_LAS unsigned char* lds, const Gemm g, const Sched& S, const Epi& E, int wv) {
    unsigned z_ = 0u; asm volatile("" : "+s"(z_)); int tid_ = wv * 64 + (int)__builtin_amdgcn_mbcnt_hi(~0u, __builtin_amdgcn_mbcnt_lo(~0u, z_)); asm volatile("" : "+v"(tid_));
    const int tid = tid_, wid = __builtin_amdgcn_readfirstlane(tid >> 6), lane = tid & 63, wr = wid >> 2, wc = wid & 3, fr = lane & 15, fq = lane >> 4;
    const int K = g.K, nt = K / BK;
    unsigned voffA[2], voffB[2];
#pragma unroll
    for (int i = 0; i < 2; ++i) { int R, C; stage_rc(tid * 16 + i * 8192, R, C); const int Rb = Epi::PERM ? ((R & ~31) + perm32(R & 31)) : R;
        voffA[i] = (unsigned)(R * K + C) * 2u; voffB[i] = (unsigned)(Rb * K + C) * 2u; }
    const size_t kstep = (size_t)(BK * 2);
    const size_t hstep = (size_t)HALF * K * 2;
    const size_t tstep = 2 * hstep;
    const unsigned ldsw = (unsigned)wid * 1024u;
    const int aoff = lds_byte(wr * 64 + fr, fq * 8), boff = lds_byte(wc * 32 + fr, fq * 8);
#define PG8_SA(b, h) (((b) * 2 + (h)) * HTB)
#define PG8_SB(b, h) ((4 + (b) * 2 + (h)) * HTB)
#define PG8_STAGE(bufoff, gbase, voff) do { _Pragma("unroll") for (int _i = 0; _i < 2; ++_i) \
        __builtin_amdgcn_global_load_lds((const unsigned*)((const char*)(gbase) + (voff)[_i]), (PG8_LAS unsigned*)(lds + (bufoff) + ldsw + _i * 8192), 16, 0, 0); } while (0)
#define PG8_LDA(dst, b, h) do { _Pragma("unroll") for (int m = 0; m < 4; ++m) _Pragma("unroll") for (int k = 0; k < 2; ++k) dst[m][k] = *(const PG8_LAS bf16x8*)(lds + PG8_SA(b, h) + aoff + m * 2048 + k * 1024); } while (0)
#define PG8_LDB(dst, b, h) do { _Pragma("unroll") for (int n = 0; n < 2; ++n) _Pragma("unroll") for (int k = 0; k < 2; ++k) dst[n][k] = *(const PG8_LAS bf16x8*)(lds + PG8_SB(b, h) + boff + n * 2048 + k * 1024); } while (0)
#define PG8_CAT8(x_, y_) __builtin_shufflevector(__builtin_bit_cast(pg8_i32x4, (x_)), __builtin_bit_cast(pg8_i32x4, (y_)), 0, 1, 2, 3, 4, 5, 6, 7)
#define PG8_MMA(ai, bj, At, Bt) do { __builtin_amdgcn_s_setprio(1); _Pragma("unroll") for (int m = 0; m < 4; ++m) _Pragma("unroll") for (int n = 0; n < 2; ++n) { \
        if constexpr (FP8) { asm volatile("v_mfma_scale_f32_16x16x128_f8f6f4 %0, %1, %2, %0, %3, %3 op_sel_hi:[0,0,0]" : "+v"(acc[ai][bj][m][n]) : "v"(PG8_CAT8(Bt[n][0], Bt[n][1])), "v"(PG8_CAT8(At[m][0], At[m][1])), "v"(sc1)); } \
        else { _Pragma("unroll") for (int k = 0; k < 2; ++k) acc[ai][bj][m][n] = __builtin_amdgcn_mfma_f32_16x16x32_bf16(Bt[n][k], At[m][k], acc[ai][bj][m][n], 0, 0, 0); } } \
        __builtin_amdgcn_s_setprio(0); } while (0)
#define PG8_WAIT_V(n) asm volatile("s_waitcnt vmcnt(" #n ")" ::: "memory")
#define PG8_WAIT_L(n) asm volatile("s_waitcnt lgkmcnt(" #n ")" ::: "memory")
#define PG8_BAR __builtin_amdgcn_s_barrier()
#define PG8_SCHED __builtin_amdgcn_sched_barrier(0)
    Unit cur, nxt; int ui = 0;
    [[maybe_unused]] int sc1 = 0x7F7F7F7F; if constexpr (FP8) asm volatile("" : "+v"(sc1));
    if (!S.next(0, cur)) return;
    f32x4 acc[2][2][4][2];
#pragma unroll
    for (int a = 0; a < 2; ++a)
#pragma unroll
        for (int b = 0; b < 2; ++b)
#pragma unroll
            for (int m = 0; m < 4; ++m)
#pragma unroll
                for (int n = 0; n < 2; ++n) acc[a][b][m][n] = (f32x4){0.f, 0.f, 0.f, 0.f};
    bf16x8 At[4][2], B0[2][2], B1[2][2];
    const char* cA = (const char*)g.A + (size_t)cur.pm * tstep; const char* cB = (const char*)g.Bt + (size_t)cur.pn * tstep;
    S.a_ready(cur);
    if constexpr (SP2) {
        PG8_STAGE(PG8_SB(0, 0), cB, voffB); PG8_STAGE(PG8_SB(0, 1), cB + hstep, voffB); PG8_STAGE(PG8_SA(0, 0), cA, voffA); PG8_STAGE(PG8_SA(0, 1), cA + hstep, voffA);
        if (wr == 1) PG8_BAR;
        PG8_WAIT_V(2); PG8_BAR;
        PG8_STAGE(PG8_SB(1, 0), cB + kstep, voffB); PG8_STAGE(PG8_SA(1, 0), cA + kstep, voffA); PG8_STAGE(PG8_SB(1, 1), cB + hstep + kstep, voffB);
        PG8_WAIT_V(6); PG8_BAR;
    } else {
        PG8_STAGE(PG8_SB(0, 0), cB, voffB); PG8_STAGE(PG8_SA(0, 0), cA, voffA); PG8_STAGE(PG8_SB(0, 1), cB + hstep, voffB); PG8_STAGE(PG8_SA(0, 1), cA + hstep, voffA);
        if (wr == 1) PG8_BAR;
        PG8_WAIT_V(4); PG8_BAR;
        PG8_STAGE(PG8_SB(1, 0), cB + kstep, voffB); PG8_STAGE(PG8_SA(1, 0), cA + kstep, voffA); PG8_STAGE(PG8_SB(1, 1), cB + hstep + kstep, voffB);
        PG8_WAIT_V(6); PG8_BAR;
    }
    for (;;) {
        const bool has_next = S.next(ui + 1, nxt);
        const char* nA = has_next ? (const char*)g.A + (size_t)nxt.pm * tstep : cA; const char* nB = has_next ? (const char*)g.Bt + (size_t)nxt.pn * tstep : cB;
        for (int t = 0; t < nt; t += 2) {
            const bool last = (t == nt - 2);
            const char* a1 = cA + (size_t)(t + 1) * kstep;
            const char* a2 = last ? nA : cA + (size_t)(t + 2) * kstep; const char* b2 = last ? nB : cB + (size_t)(t + 2) * kstep;
            const char* a3 = a2 + kstep; const char* b3 = b2 + kstep;
            if (last && has_next) S.a_ready(nxt);
            if constexpr (SP2) {
            PG8_LDB(B0, 0, 0); PG8_LDB(B1, 0, 1); PG8_SCHED; PG8_LDA(At, 0, 0); PG8_STAGE(PG8_SA(1, 1), a1 + hstep, voffA);
            PG8_WAIT_V(8); PG8_WAIT_L(0); PG8_BAR; PG8_MMA(0, 0, At, B0); PG8_MMA(0, 1, At, B1); PG8_BAR; PG8_SCHED;
            PG8_LDA(At, 0, 1); PG8_STAGE(PG8_SB(0, 0), b2, voffB); PG8_STAGE(PG8_SB(0, 1), b2 + hstep, voffB); PG8_STAGE(PG8_SA(0, 0), a2, voffA);
            PG8_WAIT_V(8); PG8_WAIT_L(0); PG8_BAR; PG8_MMA(1, 0, At, B0); PG8_MMA(1, 1, At, B1); PG8_BAR; PG8_SCHED;
            PG8_LDB(B0, 1, 0); PG8_LDB(B1, 1, 1); PG8_SCHED; PG8_LDA(At, 1, 0); PG8_STAGE(PG8_SA(0, 1), a2 + hstep, voffA);
            PG8_WAIT_V(8); PG8_WAIT_L(0); PG8_BAR; PG8_MMA(0, 0, At, B0); PG8_MMA(0, 1, At, B1); PG8_BAR; PG8_SCHED;
            PG8_LDA(At, 1, 1); PG8_STAGE(PG8_SB(1, 0), b3, voffB); PG8_STAGE(PG8_SB(1, 1), b3 + hstep, voffB); PG8_STAGE(PG8_SA(1, 0), a3, voffA);
            PG8_WAIT_V(8); PG8_WAIT_L(0); PG8_BAR; PG8_MMA(1, 0, At, B0); PG8_MMA(1, 1, At, B1); PG8_BAR; PG8_SCHED;
            } else {
            PG8_LDB(B0, 0, 0); PG8_SCHED; PG8_LDA(At, 0, 0); PG8_STAGE(PG8_SA(1, 1), a1 + hstep, voffA);
            PG8_WAIT_L(8); PG8_BAR; PG8_WAIT_L(0); PG8_MMA(0, 0, At, B0); PG8_BAR; PG8_SCHED;
            PG8_LDB(B1, 0, 1); PG8_STAGE(PG8_SB(0, 0), b2, voffB);
            PG8_BAR; PG8_WAIT_L(0); PG8_MMA(0, 1, At, B1); PG8_BAR;
            PG8_LDA(At, 0, 1); PG8_STAGE(PG8_SA(0, 0), a2, voffA);
            PG8_BAR; PG8_WAIT_L(0); PG8_MMA(1, 0, At, B0); PG8_BAR; PG8_SCHED;
            PG8_STAGE(PG8_SB(0, 1), b2 + hstep, voffB);
            PG8_WAIT_V(6); PG8_BAR; PG8_MMA(1, 1, At, B1); PG8_BAR;
            PG8_LDB(B0, 1, 0); PG8_SCHED; PG8_LDA(At, 1, 0); PG8_STAGE(PG8_SA(0, 1), a2 + hstep, voffA);
            PG8_WAIT_L(8); PG8_BAR; PG8_WAIT_L(0); PG8_MMA(0, 0, At, B0); PG8_BAR; PG8_SCHED;
            PG8_LDB(B1, 1, 1); PG8_STAGE(PG8_SB(1, 0), b3, voffB);
            PG8_BAR; PG8_WAIT_L(0); PG8_MMA(0, 1, At, B1); PG8_BAR;
            PG8_LDA(At, 1, 1); PG8_STAGE(PG8_SA(1, 0), a3, voffA);
            PG8_BAR; PG8_WAIT_L(0); PG8_MMA(1, 0, At, B0); PG8_BAR; PG8_SCHED;
            PG8_STAGE(PG8_SB(1, 1), b3 + hstep, voffB);
            PG8_WAIT_V(6); PG8_BAR; PG8_MMA(1, 1, At, B1); PG8_BAR;
            }
        }
        if constexpr (ALIGN_EPI) { if (wr == 0) PG8_BAR; }
        if constexpr (!Epi::AFTER_DRAIN) { E(acc, cur, wr, wc, fr, fq); S.done(cur); }
        if (!has_next) break;
#pragma unroll
        for (int a = 0; a < 2; ++a)
#pragma unroll
            for (int b = 0; b < 2; ++b)
#pragma unroll
                for (int m = 0; m < 4; ++m)
#pragma unroll
                    for (int n = 0; n < 2; ++n) acc[a][b][m][n] = (f32x4){0.f, 0.f, 0.f, 0.f};
        cur = nxt; cA = nA; cB = nB; ++ui;
        if constexpr (ALIGN_EPI) { if (wr == 1) PG8_BAR; }
    }
    PG8_WAIT_V(0);
    if constexpr (!ALIGN_EPI) { if (wr == 0) PG8_BAR; }
    PG8_BAR;
    if constexpr (Epi::AFTER_DRAIN) { E.fused(acc, cur, wr, wc, fr, fq, lds, wid, lane); S.done(cur); }
#undef PG8_SA
#undef PG8_SB
#undef PG8_STAGE
#undef PG8_LDA
#undef PG8_LDB
#undef PG8_MMA
#undef PG8_WAIT_V
#undef PG8_WAIT_L
#undef PG8_BAR
#undef PG8_SCHED
}
}

struct TJob { const float* src; const float* kscale; bf16_t* dst; int ld, col0, nvalid, K, n0, k0, f8; float scale; };

__device__ __forceinline__ int main_srccol(int n, float& scale, int& nvalid) {
    scale = 1.0f; nvalid = 64;
    if (n < 512) { scale = 0.125f * LOG2E; return n; }
    if (n < 1024) { scale = 0.125f * LOG2E; return 768 + (n - 512); }
    if (n < 1536) { scale = 0.125f * LOG2E; return 2072 + (n - 1024); }
    if (n < 1664) return 512 + (n - 1536);
    if (n < 1792) return 1536 + (n - 1664);
    if (n < 1920) return 1792 + (n - 1792);
    if (n < 2432) return 2584 + (n - 1920);
    if (n < 2560) return 1280 + (n - 2432);
    if (n < 2688) return 1408 + (n - 2560);
    if (n < 2752) { nvalid = 24; return 2048; }
    if (n < 2816) { nvalid = 0; return 0; }
    return 3608 + (n - 2816);
}
__device__ __forceinline__ int vt_srccol(int n, int& nvalid) {
    nvalid = 64;
    if (n < 128) return 640 + n;
    if (n < 256) return 1664 + (n - 128);
    if (n < 384) return 1920 + (n - 256);
    if (n < 896) return 3096 + (n - 384);
    nvalid = 0; return 0;
}

constexpr int TJ_IN = 92 * 8, TJ_VT = 16 * 8, TJ_BR = 16 * 4, TJ_OUT = 16 * 8, TJ_Q = 32 * 8, TJ_W1 = 2 * 16, TJ_W2 = 1;
constexpr int TJ_LAYER = TJ_IN + TJ_VT + 3 * TJ_BR + TJ_OUT + TJ_Q + 2 * TJ_W1 + 2 * TJ_W2;

__device__ __forceinline__ TJob decode_job(const Params& p, int job) {
    const int layer = job / TJ_LAYER; int j = job % TJ_LAYER;
    unsigned char* wl = p.ws + OFF_W + (size_t)layer * LW;
    TJob t; t.kscale = nullptr; t.scale = 1.0f; t.nvalid = 64; t.f8 = 0;
    if (j < TJ_IN) { const int nt = j / 8, kt = j % 8; t.col0 = main_srccol(nt * 64, t.scale, t.nvalid);
        t.src = p.w_in + (size_t)layer * DM * D_IN; t.ld = D_IN; t.dst = (bf16_t*)(wl + W_IN); t.K = 1024; t.n0 = nt * 64; t.k0 = kt * 128;
        if (nt >= 44) { t.f8 = 1; t.scale = WG_SCALE; t.n0 = nt * 64 - 2816; t.dst = (bf16_t*)(p.ws + OFF_WG8 + (size_t)layer * 3072 * 1024); }
        return t; }
    j -= TJ_IN;
    if (j < TJ_VT) { const int nt = j / 8, kt = j % 8; t.col0 = vt_srccol(nt * 64, t.nvalid);
        t.src = p.w_in + (size_t)layer * DM * D_IN; t.ld = D_IN; t.dst = (bf16_t*)(wl + W_VT); t.K = 1024; t.n0 = nt * 64; t.k0 = kt * 128; return t; }
    j -= TJ_VT;
    if (j < 3 * TJ_BR) { const int i = j / TJ_BR, jj = j % TJ_BR, nt = jj / 4, kt = jj % 4;
        t.src = p.w_branch + ((size_t)layer * 3 + i) * 512 * 1024; t.ld = 1024; t.col0 = nt * 64; t.dst = (bf16_t*)(wl + W_BR) + (size_t)i * 1024 * 512; t.K = 512; t.n0 = nt * 64; t.k0 = kt * 128; return t; }
    j -= 3 * TJ_BR;
    if (j < TJ_OUT) { const int nt = j / 8, kt = j % 8;
        t.src = p.w_out + (size_t)layer * 1024 * 1024; t.ld = 1024; t.col0 = nt * 64; t.dst = (bf16_t*)(wl + W_OUT); t.K = 1024; t.n0 = nt * 64; t.k0 = kt * 128; return t; }
    j -= TJ_OUT;
    if (j < TJ_Q) { const int nt = j / 8, kt = j % 8;
        t.src = p.peer_wq + (size_t)layer * 1024 * 2048; t.ld = 2048; t.col0 = nt * 64; t.dst = (bf16_t*)(p.ws + OFF_WQ8 + (size_t)layer * 2048 * 1024); t.f8 = 1; t.scale = WG_SCALE; t.K = 1024; t.n0 = nt * 64; t.k0 = kt * 128; t.kscale = p.norm2 + layer * DM; return t; }
    j -= TJ_Q;
    if (j < 2 * TJ_W1) { const int i = j / TJ_W1, jj = j % TJ_W1, nt = jj / 16, kt = jj % 16;
        t.src = p.cmp_w1 + ((size_t)layer * 2 + i) * 2048 * 128; t.ld = 128; t.col0 = nt * 64; t.dst = (bf16_t*)(wl + W_1T) + (size_t)i * 128 * 2048; t.K = 2048; t.n0 = nt * 64; t.k0 = kt * 128; return t; }
    j -= 2 * TJ_W1;
    { const int i = j;
        t.src = p.cmp_w2 + ((size_t)layer * 2 + i) * 128 * 64; t.ld = 64; t.col0 = 0; t.dst = (bf16_t*)(wl + W_2T) + (size_t)i * 64 * 128; t.K = 128; t.n0 = 0; t.k0 = 0; return t; }
}
__device__ __forceinline__ void tjob_load(const TJob& t, int tid, f32x4 (&v)[4], float (&sc)[4]) {
    const int c4 = (tid & 15) * 4;
#pragma unroll
    for (int ps = 0; ps < 4; ++ps) { const int kk = (tid >> 4) + 32 * ps;
        v[ps] = (f32x4){0.f, 0.f, 0.f, 0.f};
        if (c4 < t.nvalid) v[ps] = *(const f32x4*)(t.src + (size_t)(t.k0 + kk) * t.ld + t.col0 + c4);
        sc[ps] = t.scale * (t.kscale ? t.kscale[t.k0 + kk] : 1.0f); }
}
template <bool TICKET>
__device__ __forceinline__ void conv_jobs(const Params& p, LAS unsigned char* lds, int tid, const int jbegin, const int jend, unsigned* ctr) {
    constexpr int TP = 136;
    volatile LAS int* slot = (volatile LAS int*)(lds + 2 * 64 * TP * 2);
    int job = jbegin + (int)blockIdx.x, buf = 0, nj2 = 0, kq = 0;
    if (TICKET) {
        if (tid == 0) { slot[0] = jbegin + (int)atomicAdd(ctr, 1u); slot[1] = jbegin + (int)atomicAdd(ctr, 1u); }
        __syncthreads();
        job = __builtin_amdgcn_readfirstlane(slot[0]); nj2 = __builtin_amdgcn_readfirstlane(slot[1]);
    }
    if (job >= jend) return;
    TJob cur = decode_job(p, job);
    f32x4 v[4]; float sc[4];
    tjob_load(cur, tid, v, sc);
    for (;;) {
        LAS bf16_t* T = (LAS bf16_t*)(lds + buf * (64 * TP * 2));
        if (TICKET) { if (tid == 0) slot[(kq + 2) & 3] = jbegin + (int)atomicAdd(ctr, 1u); }
        const int c4 = (tid & 15) * 4;
#pragma unroll
        for (int ps = 0; ps < 4; ++ps) { const int kk = (tid >> 4) + 32 * ps;
#pragma unroll
            for (int i = 0; i < 4; ++i) T[(c4 + i) * TP + kk] = (bf16_t)(cvt_pk_bf16(v[ps][i] * sc[ps], 0.f) & 0xffffu); }
        const int nj = TICKET ? nj2 : job + (int)gridDim.x; const bool more = nj < jend;
        TJob nxt = cur;
        if (more) { nxt = decode_job(p, nj); tjob_load(nxt, tid, v, sc); }
        __syncthreads();
        if (TICKET) nj2 = __builtin_amdgcn_readfirstlane(slot[(kq + 2) & 3]);
        { const int n = tid >> 3, kc = (tid & 7) * 16;
          const u32x4 w0 = *(const LAS u32x4*)(T + n * TP + kc), w1 = *(const LAS u32x4*)(T + n * TP + kc + 8);
          if (cur.f8) {
              u32x4 o;
#pragma unroll
              for (int i = 0; i < 2; ++i) { unsigned a = 0u, b = 0u;
                  a = __builtin_amdgcn_cvt_pk_fp8_f32(bf_lo(w0[2 * i]), bf_hi(w0[2 * i]), a, false); a = __builtin_amdgcn_cvt_pk_fp8_f32(bf_lo(w0[2 * i + 1]), bf_hi(w0[2 * i + 1]), a, true);
                  b = __builtin_amdgcn_cvt_pk_fp8_f32(bf_lo(w1[2 * i]), bf_hi(w1[2 * i]), b, false); b = __builtin_amdgcn_cvt_pk_fp8_f32(bf_lo(w1[2 * i + 1]), bf_hi(w1[2 * i + 1]), b, true);
                  o[i] = a; o[2 + i] = b; }
              *(u32x4*)((unsigned char*)cur.dst + (size_t)(cur.n0 + n) * cur.K + cur.k0 + kc) = o;
          } else {
              bf16_t* dp = cur.dst + (size_t)(cur.n0 + n) * cur.K + cur.k0 + kc;
              *(u32x4*)dp = w0; *(u32x4*)(dp + 8) = w1; } }
        if (!more) break;
        cur = nxt; job = nj; buf ^= 1; ++kq;
    }
}

__device__ __forceinline__ void conv_flat(const float* __restrict__ src, bf16_t* __restrict__ dst, size_t n, int wv) {
    const size_t nth = (size_t)gridDim.x * NTHREADS;
    for (size_t i = ((size_t)opaque_bid() * NTHREADS + opaque_tid(wv)) * 8; i < n; i += nth * 8) {
        const f32x4 a = __builtin_nontemporal_load((const f32x4*)(src + i)), b = __builtin_nontemporal_load((const f32x4*)(src + i + 4));
        u32x4 w; w.x = cvt_pk_bf16(a[0], a[1]); w.y = cvt_pk_bf16(a[2], a[3]); w.z = cvt_pk_bf16(b[0], b[1]); w.w = cvt_pk_bf16(b[2], b[3]);
        *(u32x4*)(dst + i) = w;
    }
}

__device__ __forceinline__ void conv_flat_fp4(const float* __restrict__ src, unsigned char* __restrict__ dst, size_t n, float scale, int wv) {
    const size_t nth = (size_t)gridDim.x * NTHREADS;
    for (size_t i = ((size_t)opaque_bid() * NTHREADS + opaque_tid(wv)) * 16; i < n; i += nth * 16) {
        u32x2 w;
#pragma unroll
        for (int q = 0; q < 2; ++q) {
            f32x4 a = __builtin_nontemporal_load((const f32x4*)(src + i + 8 * q)), b = __builtin_nontemporal_load((const f32x4*)(src + i + 8 * q + 4));
#pragma unroll
            for (int e = 0; e < 4; ++e) { a[e] = fminf(fmaxf(a[e] * scale, -6.0f), 6.0f); b[e] = fminf(fmaxf(b[e] * scale, -6.0f), 6.0f); }
            unsigned pk = 0u;
            pk = __builtin_amdgcn_cvt_scalef32_pk_fp4_f32(pk, a[0], a[1], 1.0f, 0);
            pk = __builtin_amdgcn_cvt_scalef32_pk_fp4_f32(pk, a[2], a[3], 1.0f, 1);
            pk = __builtin_amdgcn_cvt_scalef32_pk_fp4_f32(pk, b[0], b[1], 1.0f, 2);
            pk = __builtin_amdgcn_cvt_scalef32_pk_fp4_f32(pk, b[2], b[3], 1.0f, 3);
            w[q] = pk;
        }
        *(u32x2*)(dst + (i >> 1)) = w;
    }
}

__device__ __forceinline__ void rms_row_to_bf16(const float* __restrict__ xr, const float* __restrict__ g, bf16_t* __restrict__ hr, unsigned char* __restrict__ h8r, int lane) {
    const float4 a0 = *(const float4*)(xr + 8 * lane), a1 = *(const float4*)(xr + 8 * lane + 4);
    const float4 b0 = *(const float4*)(xr + 512 + 8 * lane), b1 = *(const float4*)(xr + 512 + 8 * lane + 4);
    float ss = a0.x * a0.x + a0.y * a0.y + a0.z * a0.z + a0.w * a0.w + a1.x * a1.x + a1.y * a1.y + a1.z * a1.z + a1.w * a1.w
             + b0.x * b0.x + b0.y * b0.y + b0.z * b0.z + b0.w * b0.w + b1.x * b1.x + b1.y * b1.y + b1.z * b1.z + b1.w * b1.w;
    ss = wave_sum(ss);
    const float rs = rsqrtf(ss * (1.0f / DM) + RMS_EPS);
    const float4 g0 = *(const float4*)(g + 8 * lane), g1 = *(const float4*)(g + 8 * lane + 4), g2 = *(const float4*)(g + 512 + 8 * lane), g3 = *(const float4*)(g + 512 + 8 * lane + 4);
    u32x4 w;
    w.x = cvt_pk_bf16(a0.x * rs * g0.x, a0.y * rs * g0.y); w.y = cvt_pk_bf16(a0.z * rs * g0.z, a0.w * rs * g0.w);
    w.z = cvt_pk_bf16(a1.x * rs * g1.x, a1.y * rs * g1.y); w.w = cvt_pk_bf16(a1.z * rs * g1.z, a1.w * rs * g1.w);
    *(u32x4*)(hr + 8 * lane) = w;
    { u32x2 o; unsigned a = 0u, b = 0u;
      a = __builtin_amdgcn_cvt_pk_fp8_f32(a0.x * rs * g0.x, a0.y * rs * g0.y, a, false); a = __builtin_amdgcn_cvt_pk_fp8_f32(a0.z * rs * g0.z, a0.w * rs * g0.w, a, true);
      b = __builtin_amdgcn_cvt_pk_fp8_f32(a1.x * rs * g1.x, a1.y * rs * g1.y, b, false); b = __builtin_amdgcn_cvt_pk_fp8_f32(a1.z * rs * g1.z, a1.w * rs * g1.w, b, true);
      o.x = a; o.y = b; *(u32x2*)(h8r + 8 * lane) = o;
      a = 0u; b = 0u;
      a = __builtin_amdgcn_cvt_pk_fp8_f32(b0.x * rs * g2.x, b0.y * rs * g2.y, a, false); a = __builtin_amdgcn_cvt_pk_fp8_f32(b0.z * rs * g2.z, b0.w * rs * g2.w, a, true);
      b = __builtin_amdgcn_cvt_pk_fp8_f32(b1.x * rs * g3.x, b1.y * rs * g3.y, b, false); b = __builtin_amdgcn_cvt_pk_fp8_f32(b1.z * rs * g3.z, b1.w * rs * g3.w, b, true);
      o.x = a; o.y = b; *(u32x2*)(h8r + 512 + 8 * lane) = o; }
    w.x = cvt_pk_bf16(b0.x * rs * g2.x, b0.y * rs * g2.y); w.y = cvt_pk_bf16(b0.z * rs * g2.z, b0.w * rs * g2.w);
    w.z = cvt_pk_bf16(b1.x * rs * g3.x, b1.y * rs * g3.y); w.w = cvt_pk_bf16(b1.z * rs * g3.z, b1.w * rs * g3.w);
    *(u32x4*)(hr + 512 + 8 * lane) = w;
}

__device__ __forceinline__ void phase_prologue(const Params& p, LAS unsigned char* lds, int wv) {
    const int tid = opaque_tid(wv), lane = tid & 63, wid = tid >> 6;
    if (blockIdx.x < 64) {
        const int lj = blockIdx.x >> 4, f = (blockIdx.x & 15) * 8 + (tid & 7), kg = tid >> 3;
        const float* pos = p.cmp_pos + (size_t)lj * 2048; const float* w1 = p.cmp_w1 + (size_t)lj * 2048 * 128;
        float s = 0.f;
#pragma unroll 8
        for (int i = 0; i < 32; ++i) { const int k = kg + 64 * i; s += pos[k] * w1[(size_t)k * 128 + f]; }
        LAS float* red = (LAS float*)(lds + 40960);
        red[tid] = s;
        __syncthreads();
        if (tid < 8) { float a = 0.f;
            for (int g = 0; g < 64; ++g) a += red[g * 8 + tid];
            ((float*)(p.ws + OFF_CBIAS))[lj * 128 + (blockIdx.x & 15) * 8 + tid] = a; }
    }
    conv_jobs<false>(p, lds, tid, 0, TJ_LAYER, nullptr);
    for (int l = 0; l < NLAYER; ++l) conv_flat(p.peer_keys + (size_t)l * 262144, (bf16_t*)(p.ws + OFF_W + (size_t)l * LW + W_KP), 262144, wv);
    for (int l = 0; l < 1; ++l) {
        conv_flat_fp4(p.peer_u + (size_t)l * 16384 * 1024, p.ws + OFF_U + (size_t)l * 16384 * 512, (size_t)16384 * 1024, U4_SCALE, wv);
        conv_flat_fp4(p.peer_v + (size_t)l * 16384 * 1024, p.ws + OFF_V + (size_t)l * 16384 * 512, (size_t)16384 * 1024, V4_SCALE, wv);
    }
    const int gw = blockIdx.x * 8 + wid, nw = gridDim.x * 8;
    for (int r = gw; r < S_LEN; r += nw) rms_row_to_bf16(p.x + (size_t)r * DM, p.norm1, (bf16_t*)(p.ws + OFF_H) + (size_t)r * DM, p.ws + OFF_H8 + (size_t)r * DM, lane);
}

__device__ __forceinline__ u32x4 pack_acc(const f32x4& v0, const f32x4& v1) {
    u32x4 w; w.x = cvt_pk_bf16(v0[0], v0[1]); w.y = cvt_pk_bf16(v0[2], v0[3]); w.z = cvt_pk_bf16(v1[0], v1[1]); w.w = cvt_pk_bf16(v1[2], v1[3]); return w;
}
struct EpiGate {
    static constexpr bool PERM = true, AFTER_DRAIN = false;
    unsigned char* g8;
    __device__ __forceinline__ void operator()(const f32x4 (&acc)[2][2][4][2], const pg8::Unit& u, int wr, int wc, int fr, int fq) const {
        __builtin_amdgcn_sched_barrier(0); asm volatile("s_nop 15\n\ts_nop 15" ::: "memory"); __builtin_amdgcn_sched_barrier(0);
        unsigned char* gp = g8 + ((((size_t)u.pm * 12 + u.pn) * 8 + (wr * 4 + wc)) * 8) * 1024 + (fq * 16 + fr) * 16;
        auto g8f = [](float v) { return fast_rcp(__builtin_fmaf(fast_exp2(v * (-LOG2E / WG_SCALE)), 1.0f / 255.0f, 1.0f / 255.0f)); };
#pragma unroll
        for (int ai = 0; ai < 2; ++ai)
#pragma unroll
            for (int m = 0; m < 4; ++m) {
                u32x4 w;
#pragma unroll
                for (int bj = 0; bj < 2; ++bj) { const f32x4 v0 = acc[ai][bj][m][0], v1 = acc[ai][bj][m][1];
                    unsigned w0 = 0u, w1 = 0u;
                    w0 = __builtin_amdgcn_cvt_pk_u8_f32(g8f(v0[0]), 0, w0); w0 = __builtin_amdgcn_cvt_pk_u8_f32(g8f(v0[1]), 1, w0);
                    w0 = __builtin_amdgcn_cvt_pk_u8_f32(g8f(v0[2]), 2, w0); w0 = __builtin_amdgcn_cvt_pk_u8_f32(g8f(v0[3]), 3, w0);
                    w1 = __builtin_amdgcn_cvt_pk_u8_f32(g8f(v1[0]), 0, w1); w1 = __builtin_amdgcn_cvt_pk_u8_f32(g8f(v1[1]), 1, w1);
                    w1 = __builtin_amdgcn_cvt_pk_u8_f32(g8f(v1[2]), 2, w1); w1 = __builtin_amdgcn_cvt_pk_u8_f32(g8f(v1[3]), 3, w1);
                    w[2 * bj] = w0; w[2 * bj + 1] = w1; }
                *(u32x4*)(gp + (ai * 4 + m) * 1024) = w; }
    }
};
struct EpiIn {
    static constexpr bool PERM = true, AFTER_DRAIN = false;
    bf16_t* qall; bf16_t* kall; bf16_t* rr;
    __device__ __forceinline__ void operator()(const f32x4 (&acc)[2][2][4][2], const pg8::Unit& u, int wr, int wc, int fr, int fq) const {
        const int row0 = u.pm * 256 + wr * 64 + fr;
#pragma unroll
        for (int bj = 0; bj < 2; ++bj) {
            const int col = u.pn * 256 + bj * 128 + wc * 32 + 8 * fq;
            if (col < 2432) {
                bf16_t* plane = (col < 1536) ? qall + (size_t)(col >> 6) * PLANE : kall + (size_t)((col - 1536) >> 6) * PLANE;
                const int d0 = col & 63, ks = d0 >> 4, hh = (d0 >> 3) & 1;
#pragma unroll
                for (int ai = 0; ai < 2; ++ai)
#pragma unroll
                    for (int m = 0; m < 4; ++m) { const int row = row0 + ai * 128 + m * 16;
                        *(u32x4*)(plane + ((size_t)((row >> 5) * 4 + ks) * 64 + (row & 31) + 32 * hh) * 8) = pack_acc(acc[ai][bj][m][0], acc[ai][bj][m][1]); }
            } else if (col < 2432 + RW) {
                const int c2 = col - 2432;
#pragma unroll
                for (int ai = 0; ai < 2; ++ai)
#pragma unroll
                    for (int m = 0; m < 4; ++m) { const int row = row0 + ai * 128 + m * 16;
                        *(u32x4*)(rr + (size_t)row * RW + c2) = pack_acc(acc[ai][bj][m][0], acc[ai][bj][m][1]); }
            }
        }
    }
};
struct EpiVT {
    static constexpr bool PERM = true, AFTER_DRAIN = false;
    bf16_t* vall;
    __device__ __forceinline__ void operator()(const f32x4 (&acc)[2][2][4][2], const pg8::Unit& u, int wr, int wc, int fr, int fq) const {
        const int row0 = u.pm * 256 + wr * 64 + fr;
#pragma unroll
        for (int ai = 0; ai < 2; ++ai)
#pragma unroll
            for (int m = 0; m < 4; ++m) { const int row = row0 + ai * 128 + m * 16; const int pl = row >> 6, d = row & 63, dt = d >> 5;
                if (pl < 14) {
                    bf16_t* plane = vall + (size_t)pl * PLANE;
#pragma unroll
                    for (int bj = 0; bj < 2; ++bj) { const int t0 = u.pn * 256 + bj * 128 + wc * 32 + 8 * fq; const int kk0 = t0 & 31, s = kk0 >> 4, j0 = ((kk0 >> 3) & 1) * 4;
                        bf16_t* base = plane + ((size_t)(((t0 >> 5) * 2 + dt) * 2 + s) * 64) * 8 + j0;
                        const f32x4 v0 = acc[ai][bj][m][0], v1 = acc[ai][bj][m][1];
                        u32x2 a; a.x = cvt_pk_bf16(v0[0], v0[1]); a.y = cvt_pk_bf16(v0[2], v0[3]);
                        u32x2 b; b.x = cvt_pk_bf16(v1[0], v1[1]); b.y = cvt_pk_bf16(v1[2], v1[3]);
                        *(u32x2*)(base + (size_t)(d & 31) * 8) = a;
                        *(u32x2*)(base + (size_t)((d & 31) + 32) * 8) = b; }
                } }
    }
};
template <int IDX> struct EpiMix {
    static constexpr bool PERM = true, AFTER_DRAIN = false;
    const unsigned char* g8; bf16_t* mixed;
    __device__ __forceinline__ void operator()(const f32x4 (&acc)[2][2][4][2], const pg8::Unit& u, int wr, int wc, int fr, int fq) const {
        const int row0 = u.pm * 256 + wr * 64 + fr;
        const unsigned char* gp = g8 + ((((size_t)u.pm * 12 + (IDX * 4 + u.pn)) * 8 + (wr * 4 + wc)) * 8) * 1024 + (fq * 16 + fr) * 16;
#pragma unroll
        for (int ai = 0; ai < 2; ++ai)
#pragma unroll
            for (int m = 0; m < 4; ++m) { const int row = row0 + ai * 128 + m * 16;
                const u32x4 gg = *(const u32x4*)(gp + (ai * 4 + m) * 1024);
#pragma unroll
                for (int bj = 0; bj < 2; ++bj) { const int col = u.pn * 256 + bj * 128 + wc * 32 + 8 * fq;
                    const unsigned gx = gg[2 * bj], gy = gg[2 * bj + 1];
                    const f32x4 v0 = acc[ai][bj][m][0], v1 = acc[ai][bj][m][1];
                    constexpr float Q = 1.0f / 255.0f;
                    float o[8];
                    o[0] = (float)(gx & 255u) * Q * v0[0]; o[1] = (float)((gx >> 8) & 255u) * Q * v0[1]; o[2] = (float)((gx >> 16) & 255u) * Q * v0[2]; o[3] = (float)(gx >> 24) * Q * v0[3];
                    o[4] = (float)(gy & 255u) * Q * v1[0]; o[5] = (float)((gy >> 8) & 255u) * Q * v1[1]; o[6] = (float)((gy >> 16) & 255u) * Q * v1[2]; o[7] = (float)(gy >> 24) * Q * v1[3];
                    bf16_t* mp = mixed + (size_t)row * DM + col;
                    if (IDX > 0) { const u32x4 pz = *(const u32x4*)mp;
                        o[0] += bf_lo(pz.x); o[1] += bf_hi(pz.x); o[2] += bf_lo(pz.y); o[3] += bf_hi(pz.y); o[4] += bf_lo(pz.z); o[5] += bf_hi(pz.z); o[6] += bf_lo(pz.w); o[7] += bf_hi(pz.w); }
                    u32x4 w; w.x = cvt_pk_bf16(o[0], o[1]); w.y = cvt_pk_bf16(o[2], o[3]); w.z = cvt_pk_bf16(o[4], o[5]); w.w = cvt_pk_bf16(o[6], o[7]);
                    *(u32x4*)mp = w; } }
    }
};
struct BranchOrder {
    pg8::StaticOrder so;
    __host__ __device__ void init(int G_, int c_) { so.init(S_LEN, 1024, G_, c_); }
    __host__ __device__ bool next(int i, pg8::Unit& u) const {
        const int r = i / 3, br = i - 3 * r;
        if (!so.next(r, u)) return false;
        u.pm += 64 * br; u.pn += 4 * br; return true;
    }
    __device__ __forceinline__ void a_ready(const pg8::Unit&) const {}
    __device__ __forceinline__ void done(const pg8::Unit&) const {}
};
struct EpiMix3 {
    static constexpr bool PERM = true, AFTER_DRAIN = false;
    const unsigned char* rr; bf16_t* mixed;
    __device__ __forceinline__ void operator()(const f32x4 (&acc)[2][2][4][2], const pg8::Unit& u, int wr, int wc, int fr, int fq) const {
        const int br = u.pn >> 2; pg8::Unit v; v.pm = u.pm - 64 * br; v.pn = u.pn & 3;
        if (br == 0) { EpiMix<0> e{rr, mixed}; e(acc, v, wr, wc, fr, fq); }
        else if (br == 1) { EpiMix<1> e{rr, mixed}; e(acc, v, wr, wc, fr, fq); }
        else { EpiMix<2> e{rr, mixed}; e(acc, v, wr, wc, fr, fq); }
    }
};
__device__ __forceinline__ float row_rstd(const float* rowss, int row) {
    const f32x4* pp = (const f32x4*)(rowss + (size_t)row * 16);
    const f32x4 a = pp[0], b = pp[1], c = pp[2], d = pp[3];
    const float s = ((a[0] + a[1]) + (a[2] + a[3])) + ((b[0] + b[1]) + (b[2] + b[3])) + ((c[0] + c[1]) + (c[2] + c[3])) + ((d[0] + d[1]) + (d[2] + d[3]));
    return rsqrtf(s * (1.0f / DM) + RMS_EPS);
}
template <bool BASE_BF16> struct EpiOut {
    static constexpr bool PERM = true, AFTER_DRAIN = false;
    const void* base; bf16_t* x1b; float* rowss; unsigned char* x8;
    __device__ __forceinline__ void operator()(const f32x4 (&acc)[2][2][4][2], const pg8::Unit& u, int wr, int wc, int fr, int fq) const {
        const int row0 = u.pm * 256 + wr * 64 + fr;
#pragma unroll
        for (int ai = 0; ai < 2; ++ai)
#pragma unroll
            for (int m = 0; m < 4; ++m) { const int row = row0 + ai * 128 + m * 16; float ss = 0.f;
#pragma unroll
                for (int bj = 0; bj < 2; ++bj) { const int col = u.pn * 256 + bj * 128 + wc * 32 + 8 * fq; const size_t off = (size_t)row * DM + col;
                    f32x4 b0, b1;
                    if (BASE_BF16) { const u32x4 w = *(const u32x4*)((const bf16_t*)base + off);
                        b0 = (f32x4){bf_lo(w.x), bf_hi(w.x), bf_lo(w.y), bf_hi(w.y)}; b1 = (f32x4){bf_lo(w.z), bf_hi(w.z), bf_lo(w.w), bf_hi(w.w)}; }
                    else { b0 = *(const f32x4*)((const float*)base + off); b1 = *(const f32x4*)((const float*)base + off + 4); }
                    const f32x4 x0 = b0 + acc[ai][bj][m][0], x1 = b1 + acc[ai][bj][m][1];
                    *(u32x4*)(x1b + off) = pack_acc(x0, x1);
                    { u32x2 o; unsigned a = 0u, b = 0u;
                      a = __builtin_amdgcn_cvt_pk_fp8_f32(x0[0] * X8_SCALE, x0[1] * X8_SCALE, a, false); a = __builtin_amdgcn_cvt_pk_fp8_f32(x0[2] * X8_SCALE, x0[3] * X8_SCALE, a, true);
                      b = __builtin_amdgcn_cvt_pk_fp8_f32(x1[0] * X8_SCALE, x1[1] * X8_SCALE, b, false); b = __builtin_amdgcn_cvt_pk_fp8_f32(x1[2] * X8_SCALE, x1[3] * X8_SCALE, b, true);
                      o.x = a; o.y = b; *(u32x2*)(x8 + off) = o; }
                    ss += x0[0] * x0[0] + x0[1] * x0[1] + x0[2] * x0[2] + x0[3] * x0[3] + x1[0] * x1[0] + x1[1] * x1[1] + x1[2] * x1[2] + x1[3] * x1[3]; }
                ss += __shfl_xor(ss, 16); ss += __shfl_xor(ss, 32);
                if (fq == 0) rowss[(size_t)row * 16 + u.pn * 4 + wc] = ss; }
    }
};
struct EpiQr {
    static constexpr bool PERM = true, AFTER_DRAIN = false;
    const float* rowss; bf16_t* qr;
    __device__ __forceinline__ void operator()(const f32x4 (&acc)[2][2][4][2], const pg8::Unit& u, int wr, int wc, int fr, int fq) const {
        const int row0 = u.pm * 256 + wr * 64 + fr;
#pragma unroll
        for (int ai = 0; ai < 2; ++ai)
#pragma unroll
            for (int m = 0; m < 4; ++m) { const int row = row0 + ai * 128 + m * 16; const float rs = row_rstd(rowss, row);
#pragma unroll
                for (int bj = 0; bj < 2; ++bj) { const int col = u.pn * 256 + bj * 128 + wc * 32 + 8 * fq;
                    const f32x4 v0 = acc[ai][bj][m][0] * rs, v1 = acc[ai][bj][m][1] * rs;
                    *(u32x4*)(qr + (size_t)row * 2048 + col) = pack_acc(v0, v1); } }
    }
};
struct Acc2 { f32x16 o0, o1; float m, l; };

__device__ __forceinline__ void load_q(bf16x8 (&qf)[4], const bf16_t* qplane, int qt, int row, int h) {
    const bf16x8* qp = (const bf16x8*)(qplane + (size_t)qt * 2048) + row + 32 * h;
#pragma unroll
    for (int ks = 0; ks < 4; ++ks) qf[ks] = qp[ks * 64];
}
struct Frag4 { bf16x8 a, b, c, d; };
__device__ __forceinline__ Frag4 load_frag4(const bf16_t* plane, int tile, int lane) {
    const bf16x8* fp = (const bf16x8*)(plane + (size_t)tile * 2048) + lane;
    Frag4 f; f.a = fp[0]; f.b = fp[64]; f.c = fp[128]; f.d = fp[192]; return f;
}
__device__ __forceinline__ bf16x8 alibi_a(int lane, int cm) {
    const unsigned b = __float_as_uint((float)(cm * (lane & 31))) >> 16;
    u32x4 w = {lane < 32 ? (b | (b << 16)) : 0u, 0u, 0u, 0u};
    return __builtin_bit_cast(bf16x8, w);
}
__device__ __forceinline__ bf16x8 alibi_b(int lane, float slope2) {
    const unsigned hi = __float_as_uint(slope2) & 0xffff0000u;
    const unsigned lo = __float_as_uint(slope2 - __uint_as_float(hi)) >> 16;
    u32x4 w = {lane < 32 ? ((hi >> 16) | (lo << 16)) : 0u, 0u, 0u, 0u};
    return __builtin_bit_cast(bf16x8, w);
}
__device__ __forceinline__ f32x16 qk_frag_b(const Frag4& k, const bf16x8 (&qf)[4], const bf16x8& ab, const bf16x8& qb) {
    f32x16 s = zero16();
    s = MFMA32(ab, qb, s);
    s = MFMA32(k.a, qf[0], s); s = MFMA32(k.b, qf[1], s); s = MFMA32(k.c, qf[2], s); s = MFMA32(k.d, qf[3], s);
    return s;
}
__device__ __forceinline__ f32x16 qk_frag(const Frag4& k, const bf16x8 (&qf)[4]) {
    f32x16 s = zero16();
    s = MFMA32(k.a, qf[0], s); s = MFMA32(k.b, qf[1], s); s = MFMA32(k.c, qf[2], s); s = MFMA32(k.d, qf[3], s);
    return s;
}
__device__ __forceinline__ void pv_frag(f32x16& o0, f32x16& o1, const Frag4& v, const float (&p)[16]) {
    const bf16x8 p0 = pack8(p[0], p[1], p[2], p[3], p[4], p[5], p[6], p[7]);
    const bf16x8 p1 = pack8(p[8], p[9], p[10], p[11], p[12], p[13], p[14], p[15]);
    o0 = MFMA32(v.a, p0, o0); o0 = MFMA32(v.b, p1, o0); o1 = MFMA32(v.c, p0, o1); o1 = MFMA32(v.d, p1, o1);
}
__device__ __forceinline__ float pair_max(float v) { const auto r = __builtin_amdgcn_permlane32_swap(__float_as_uint(v), __float_as_uint(v), false, false); return fmaxf(__uint_as_float(r[0]), __uint_as_float(r[1])); }
__device__ __forceinline__ float pair_sum(float v) { const auto r = __builtin_amdgcn_permlane32_swap(__float_as_uint(v), __float_as_uint(v), false, false); return __uint_as_float(r[0]) + __uint_as_float(r[1]); }
__device__ __forceinline__ float max16(const float (&y)[16]) {
    const float a = fmaxf(fmaxf(y[0], y[1]), fmaxf(y[2], y[3])), b = fmaxf(fmaxf(y[4], y[5]), fmaxf(y[6], y[7]));
    const float c = fmaxf(fmaxf(y[8], y[9]), fmaxf(y[10], y[11])), d = fmaxf(fmaxf(y[12], y[13]), fmaxf(y[14], y[15]));
    return fmaxf(fmaxf(a, b), fmaxf(c, d));
}
template <int CM, int KS, bool MASK> __device__ __forceinline__ void tile_logits(float (&y)[16], const f32x16& s, const float slope2, int lo, int hi) {
#pragma unroll
    for (int r = 0; r < 16; ++r) { float v = s[r];
        if (MASK) v = (KS * ROWOFF(r) <= hi && KS * ROWOFF(r) > lo) ? v : NEGV;
        y[r] = v; }
}
__device__ __forceinline__ void sm_step(Acc2& a, const float (&y)[16], float b0, const Frag4& v) {
    const float mt = pair_max(max16(y) + b0);
    if (__any(mt > a.m + 8.0f)) { const float mn = fmaxf(a.m, mt), al = fast_exp2(a.m - mn); a.o0 *= al; a.o1 *= al; a.l *= al; a.m = mn; }
    const float off = b0 - a.m;
    float p[16]; float ps = 0.f;
#pragma unroll
    for (int r = 0; r < 16; ++r) { p[r] = fast_exp2(y[r] + off); ps += p[r]; }
    a.l += ps;
    pv_frag(a.o0, a.o1, v, p);
}
__device__ __forceinline__ void store_o(bf16_t* obuf, int t, int hd, const f32x16& o0, const f32x16& o1, float sc, int lane) {
    const int h = lane >> 5;
    bf16_t* rowp = obuf + (size_t)t * 512 + hd * 64 + 4 * h;
#pragma unroll
    for (int i = 0; i < 4; ++i) {
        u32x2 w; w.x = cvt_pk_bf16(o0[4 * i] * sc, o0[4 * i + 1] * sc); w.y = cvt_pk_bf16(o0[4 * i + 2] * sc, o0[4 * i + 3] * sc);
        *(u32x2*)(rowp + 8 * i) = w;
        u32x2 z; z.x = cvt_pk_bf16(o1[4 * i] * sc, o1[4 * i + 1] * sc); z.y = cvt_pk_bf16(o1[4 * i + 2] * sc, o1[4 * i + 3] * sc);
        *(u32x2*)(rowp + 32 + 8 * i) = z;
    }
}

__device__ __forceinline__ void store_o_lds(LAS unsigned char* stg, bf16_t* obuf, int qt, int hd, const f32x16& o0, const f32x16& o1, float sc, int lane) {
    constexpr int OP = 144;
    const int h = lane >> 5;
    LAS unsigned char* wp = stg + (lane & 31) * OP + 8 * h;
#pragma unroll
    for (int i = 0; i < 4; ++i) {
        u32x2 w; w.x = cvt_pk_bf16(o0[4 * i] * sc, o0[4 * i + 1] * sc); w.y = cvt_pk_bf16(o0[4 * i + 2] * sc, o0[4 * i + 3] * sc);
        *(LAS u32x2*)(wp + 16 * i) = w;
        u32x2 z; z.x = cvt_pk_bf16(o1[4 * i] * sc, o1[4 * i + 1] * sc); z.y = cvt_pk_bf16(o1[4 * i + 2] * sc, o1[4 * i + 3] * sc);
        *(LAS u32x2*)(wp + 64 + 16 * i) = z;
    }
    __builtin_amdgcn_wave_barrier();
    bf16_t* ob = obuf + (size_t)(qt * 32) * 512 + hd * 64 + 8 * (lane & 7);
#pragma unroll
    for (int j = 0; j < 4; ++j) { const int row = (lane >> 3) + 8 * j;
        const u32x4 v = *(LAS const u32x4*)(stg + row * OP + 16 * (lane & 7));
        *(u32x4*)(ob + (size_t)row * 512) = v; }
    __builtin_amdgcn_wave_barrier();
}
template <int W, bool PF> __device__ __forceinline__ void banded_loop(Acc2& a, const bf16x8 (&qf)[4], const bf16x8& ab, const bf16x8& qb, float slope2, int t, int h,
                                                             const bf16_t* kplane, const bf16_t* vplane, int kt_hi, int kt_lo, int lane) {
    Frag4 k0, k1, v0, v1;
    k0 = load_frag4(kplane, kt_hi, lane);
    if (PF) v0 = load_frag4(vplane, kt_hi, lane);
#define BL_STEP(kc_, vc_, kn_, vn_, kt_) do { const int kt__ = (kt_); \
        const int ktn = kt__ > kt_lo ? kt__ - 1 : kt__;                   \
        kn_ = load_frag4(kplane, ktn, lane); \
        if (PF) vn_ = load_frag4(vplane, ktn, lane); else vc_ = load_frag4(vplane, kt__, lane);        \
        const f32x16 s = qk_frag_b(kc_, qf, ab, qb); \
        const int dbase = t - (kt__ * 32 + 4 * h);                        \
        float y[16]; \
        if (kt__ == kt_hi || kt__ * 32 + W <= kt_hi * 32 + 31) tile_logits<1, 1, true>(y, s, slope2, dbase - W, dbase);      \
        else tile_logits<1, 1, false>(y, s, slope2, 0, 0); \
        sm_step(a, y, -slope2 * (float)(dbase + 4 * h), vc_); } while (0)
#pragma unroll 1
    for (int kt = kt_hi; kt >= kt_lo; kt -= 2) {
        BL_STEP(k0, v0, k1, v1, kt);
        if (kt - 1 < kt_lo) break;
        BL_STEP(k1, v1, k0, v0, kt - 1);
    }
#undef BL_STEP
}

__device__ __forceinline__ void swa_unit(const Params& p, int layer, int qt, int hd, int lane, LAS unsigned char* stg) {
    const bf16_t* qplane = (const bf16_t*)(p.ws + OFF_QALL) + (size_t)hd * PLANE;
    const bf16_t* kplane = (const bf16_t*)(p.ws + OFF_KALL) + (size_t)(hd >> 2) * PLANE;
    const bf16_t* vplane = (const bf16_t*)(p.ws + OFF_VALL) + (size_t)(hd >> 2) * PLANE;
    const int h = lane >> 5, t = qt * 32 + (lane & 31);
    const float slope2 = fast_exp2(-(float)(hd + 1)) * LOG2E;
    bf16x8 qf[4]; load_q(qf, qplane, qt, lane & 31, h);
    Acc2 a; a.o0 = zero16(); a.o1 = zero16(); a.m = p.sinks[layer * 8 + hd] * LOG2E; a.l = h == 0 ? 1.0f : 0.0f;
    banded_loop<128, true>(a, qf, alibi_a(lane, 1), alibi_b(lane, slope2), slope2, t, h, kplane, vplane, qt, qt - 4 < 0 ? 0 : qt - 4, lane);
    store_o_lds(stg, (bf16_t*)(p.ws + OFF_OA), qt, hd, a.o0, a.o1, fast_rcp(pair_sum(a.l)), lane);
}

__device__ __forceinline__ void stick_unit(const Params& p, int qt, int hd, int lane, LAS unsigned char* stg) {
    const bf16_t* qplane = (const bf16_t*)(p.ws + OFF_QALL) + (size_t)(16 + hd) * PLANE;
    const bf16_t* kplane = (const bf16_t*)(p.ws + OFF_KALL) + (size_t)(6 + hd) * PLANE;
    const bf16_t* vplane = (const bf16_t*)(p.ws + OFF_VALL) + (size_t)(6 + hd) * PLANE;
    const int h = lane >> 5, t = qt * 32 + (lane & 31);
    bf16x8 qf[4]; load_q(qf, qplane, qt, lane & 31, h);
    f32x16 o0 = zero16(), o1 = zero16();
    float accl = 0.f;
    Frag4 k0 = load_frag4(kplane, qt, lane), v0 = load_frag4(vplane, qt, lane), k1, v1;
    bool done = false;
#define SB_STEP(kc_, vc_, kn_, vn_, kt_) do { const int kt__ = (kt_); \
        const int ktn = kt__ > 0 ? kt__ - 1 : 0; \
        kn_ = load_frag4(kplane, ktn, lane); vn_ = load_frag4(vplane, ktn, lane); \
        const f32x16 z = qk_frag(kc_, qf); \
        const int lim = t - (kt__ * 32 + 4 * h);             \
        float L[16], lb[16]; \
_Pragma("unroll") \
        for (int r = 0; r < 16; ++r) { \
            const float zz = z[r]; \
            const float sp = fmaxf(zz, 0.f) + __builtin_amdgcn_logf(1.0f + fast_exp2(-fabsf(zz)));     \
            const bool valid = (kt__ < qt) || (ROWOFF(r) < lim); \
            L[r] = valid ? -sp : 0.f;                      \
            lb[r] = valid ? zz - sp : NEGV;                \
        } \
        float G[4], Gp[4]; \
_Pragma("unroll") \
        for (int i = 0; i < 4; ++i) { G[i] = (L[4 * i] + L[4 * i + 1]) + (L[4 * i + 2] + L[4 * i + 3]); Gp[i] = pair_sum(G[i]) - G[i]; } \
        float a[16]; float run = 0.f; \
_Pragma("unroll") \
        for (int i = 3; i >= 0; --i) { \
            float w = accl + run + (h == 0 ? Gp[i] : 0.f);     \
_Pragma("unroll") \
            for (int e = 3; e >= 0; --e) { const int r = 4 * i + e; a[r] = fast_exp2(lb[r] + w); w += L[r]; } \
            run += G[i] + Gp[i]; \
        } \
        accl += run; \
        pv_frag(o0, o1, vc_, a); \
        if (__all(accl < -110.0f * LOG2E)) done = true;          \
    } while (0)
#pragma unroll 1
    for (int kt = qt; kt >= 0; kt -= 2) {
        SB_STEP(k0, v0, k1, v1, kt);
        if (done || kt - 1 < 0) break;
        SB_STEP(k1, v1, k0, v0, kt - 1);
        if (done) break;
    }
#undef SB_STEP
    store_o_lds(stg, (bf16_t*)(p.ws + OFF_OC), qt, hd, o0, o1, 1.0f, lane);
}

__device__ __forceinline__ void compress_unit(const Params& p, int layer, int cu, int wid, int lane, LAS unsigned char* lds) {
    const int j = cu >> 6, head = (cu >> 5) & 1, rt = cu & 31;
    const unsigned char* wl = p.ws + OFF_W + (size_t)layer * LW;
    const bf16_t* w1t = (const bf16_t*)(wl + W_1T) + (size_t)j * 128 * 2048;
    const bf16_t* w2t = (const bf16_t*)(wl + W_2T) + (size_t)j * 64 * 128;
    const float* cb = (const float*)(p.ws + OFF_CBIAS) + (layer * 2 + j) * 128;
    const bf16_t* rr = (const bf16_t*)(p.ws + OFF_R);
    const int h = lane >> 5, c = rt * 32 + (lane & 31);
    const int cc = c < 1023 ? c : 1022;
    LAS float* part = (LAS float*)lds;
    LAS u32x4* hfrag = (LAS u32x4*)(lds + 131072);
    {
        const bf16_t* xbase = rr + (size_t)(16 * cc) * RW + (j == 0 ? R_KCB : R_VCB) + head * 64 + 8 * h;
        const bf16_t* wbase = w1t + (size_t)(lane & 31) * 2048 + 8 * h;
        f32x16 acc[4];
#pragma unroll
        for (int ft = 0; ft < 4; ++ft) acc[ft] = zero16();
#pragma unroll 4
        for (int kk = 0; kk < 16; ++kk) { const int ks = wid * 16 + kk;
            const bf16x8 b = *(const bf16x8*)(xbase + (size_t)(ks >> 2) * RW + 16 * (ks & 3));
#pragma unroll
            for (int ft = 0; ft < 4; ++ft) { const bf16x8 a = *(const bf16x8*)(wbase + (size_t)ft * 32 * 2048 + 16 * ks); acc[ft] = MFMA32(a, b, acc[ft]); }
        }
#pragma unroll
        for (int ft = 0; ft < 4; ++ft)
#pragma unroll
            for (int r = 0; r < 16; ++r) part[((wid * 4 + ft) * 16 + r) * 64 + lane] = acc[ft][r];
    }
    __syncthreads();
    if (wid < 4) {
        const int ft = wid; float g[16];
#pragma unroll
        for (int r = 0; r < 16; ++r) { float s = 0.f;
#pragma unroll
            for (int w = 0; w < 8; ++w) s += part[((w * 4 + ft) * 16 + r) * 64 + lane];
            g[r] = gelu_tanh(s + cb[ft * 32 + ROWOFF(r) + 4 * h]); }
        hfrag[(ft * 2 + 0) * 64 + lane] = __builtin_bit_cast(u32x4, pack8(g[0], g[1], g[2], g[3], g[4], g[5], g[6], g[7]));
        hfrag[(ft * 2 + 1) * 64 + lane] = __builtin_bit_cast(u32x4, pack8(g[8], g[9], g[10], g[11], g[12], g[13], g[14], g[15]));
    }
    __syncthreads();
    if (wid < 2) {
        const int dt = wid; f32x16 o = zero16();
#pragma unroll
        for (int ft = 0; ft < 4; ++ft) {
            const bf16_t* wr_ = w2t + (size_t)(dt * 32 + (lane & 31)) * 128 + ft * 32 + 4 * h;
            u32x4 a0, a1;
            { const u32x2 lo = *(const u32x2*)(wr_), hi = *(const u32x2*)(wr_ + 8); a0.x = lo.x; a0.y = lo.y; a0.z = hi.x; a0.w = hi.y; }
            { const u32x2 lo = *(const u32x2*)(wr_ + 16), hi = *(const u32x2*)(wr_ + 24); a1.x = lo.x; a1.y = lo.y; a1.z = hi.x; a1.w = hi.y; }
            const u32x4 p0 = hfrag[(ft * 2 + 0) * 64 + lane], p1 = hfrag[(ft * 2 + 1) * 64 + lane];
            o = MFMA32(__builtin_bit_cast(bf16x8, a0), __builtin_bit_cast(bf16x8, p0), o);
            o = MFMA32(__builtin_bit_cast(bf16x8, a1), __builtin_bit_cast(bf16x8, p1), o);
        }
        const float keep = c < 1023 ? 1.0f : 0.0f;
        if (j == 0) {
            bf16_t* plane = (bf16_t*)(p.ws + OFF_KCMP) + (size_t)head * 65536;
#pragma unroll
            for (int i = 0; i < 4; ++i) { const int d0 = 32 * dt + 8 * i + 4 * h, ks = d0 >> 4, hh = (d0 >> 3) & 1, j0 = d0 & 7;
                u32x2 w; w.x = cvt_pk_bf16(o[4 * i] * keep, o[4 * i + 1] * keep); w.y = cvt_pk_bf16(o[4 * i + 2] * keep, o[4 * i + 3] * keep);
                *(u32x2*)(plane + ((size_t)((c >> 5) * 4 + ks) * 64 + (c & 31) + 32 * hh) * 8 + j0) = w; }
        } else {
            bf16_t* plane = (bf16_t*)(p.ws + OFF_VCMP) + (size_t)head * 65536;
            const int kk = c & 31, s = kk >> 4, r15 = kk & 15, jj = ((r15 >> 3) << 2) | (r15 & 3), hh = (r15 >> 2) & 1;
#pragma unroll
            for (int r = 0; r < 16; ++r) { const int d = 32 * dt + ROWOFF(r) + 4 * h;
                plane[((size_t)(((c >> 5) * 2 + dt) * 2 + s) * 64 + (d & 31) + 32 * hh) * 8 + jj] = (bf16_t)(cvt_pk_bf16(o[r] * keep, 0.f) & 0xffffu); }
        }
    }
    __syncthreads();
}

__device__ __forceinline__ void phase2_compress(const Params& p, int layer, LAS unsigned char* lds, int wv) {
    const int tid = opaque_tid(wv), lane = tid & 63, wid = tid >> 6;
    for (int u = opaque_bid(); u < 128; u += gridDim.x) compress_unit(p, layer, u, wid, lane, lds);
}
__device__ __forceinline__ void phase2_attn(const Params& p, int layer, LAS unsigned char* lds, int wv, int T8, int j8, int NT8) {
    const int tid = opaque_tid(wv), lane = tid & 63, wid = tid >> 6;
    for (int ui = 0; T8 + (ui >> 1) * NT8 < 32; ++ui) {
        const int pr = T8 + (ui >> 1) * NT8;
        const int qt = (ui & 1) ? 8 * (63 - pr) + 7 - j8 : 8 * pr + j8;
        swa_unit(p, layer, qt, wid, lane, lds + wid * 4608); stick_unit(p, qt, wid, lane, lds + wid * 4608);
    }
}

constexpr int IMP_PITCH = 257;
constexpr int P3_SEL = 2 * 32 * IMP_PITCH * 4;
constexpr int P3_SELU = P3_SEL + 2 * 32 * 8 * 4;
constexpr int P3_LISTS = P3_SELU + 256;
static_assert(P3_LISTS + 8 * 64 * 16 * 4 <= XB_LDS_OFF, "phase 3 LDS map");
__device__ __forceinline__ void phase3(const Params& p, int layer, LAS unsigned char* lds, int wv, int T8, int j8, int NT8) {
    const int tid = opaque_tid(wv), lane = tid & 63, wid = tid >> 6, h = lane >> 5, col = lane & 31;
    const int grp = wid >> 2, qi = 8 * (wid & 3) + (col >> 2), hd = grp * 4 + (col & 3);
    LAS float* imp = (LAS float*)lds;
    LAS unsigned* sel = (LAS unsigned*)(lds + P3_SEL);
    LAS unsigned* selu = (LAS unsigned*)(lds + P3_SELU);
    LAS unsigned* lists = (LAS unsigned*)(lds + P3_LISTS);
    const bf16_t* qplane = (const bf16_t*)(p.ws + OFF_QALL) + (size_t)(8 + hd) * PLANE;
    const bf16_t* kcmp = (const bf16_t*)(p.ws + OFF_KCMP) + (size_t)grp * 65536;
    const bf16_t* vcmp = (const bf16_t*)(p.ws + OFF_VCMP) + (size_t)grp * 65536;
    const bf16_t* kslc = (const bf16_t*)(p.ws + OFF_KALL) + (size_t)(2 + grp) * PLANE;
    const bf16_t* vslc = (const bf16_t*)(p.ws + OFF_VALL) + (size_t)(2 + grp) * PLANE;
    const bf16_t* kwin = (const bf16_t*)(p.ws + OFF_KALL) + (size_t)(4 + grp) * PLANE;
    const bf16_t* vwin = (const bf16_t*)(p.ws + OFF_VALL) + (size_t)(4 + grp) * PLANE;
    const bf16_t* rr = (const bf16_t*)(p.ws + OFF_R);
    const float slope2 = fast_exp2(-(float)(hd + 1)) * LOG2E;
    const bf16x8 qbias = alibi_b(lane, slope2);
    for (int ui = 0; T8 + (ui >> 1) * NT8 < 32; ++ui) {
        const int pr = T8 + (ui >> 1) * NT8;
        const int qt = (ui & 1) ? 8 * (63 - pr) + 7 - j8 : 8 * pr + j8;
        const int t = qt * 32 + qi;
        __syncthreads();
        for (int i = tid; i < 2 * 32 * IMP_PITCH; i += NTHREADS) imp[i] = 0.f;
        __syncthreads();
        bf16x8 qf[4]; load_q(qf, qplane, qt, qi, h);
        const bf16_t* gbp = rr + (size_t)t * RW + R_GB + hd * 3;
        const float g0 = sigmoidf_(__uint_as_float((unsigned)gbp[0] << 16)), g1 = sigmoidf_(__uint_as_float((unsigned)gbp[1] << 16)), g2 = sigmoidf_(__uint_as_float((unsigned)gbp[2] << 16));
        f32x16 ob0, ob1;
        const int ctmax = qt >> 4;
        float m = -1e4f, l = 0.f;
        {
            Frag4 kc = load_frag4(kcmp, ctmax, lane);
#pragma unroll 1
            for (int ct = ctmax; ct >= 0; --ct) {
                const Frag4 kn = load_frag4(kcmp, ct > 0 ? ct - 1 : 0, lane);
                const f32x16 s = qk_frag_b(kc, qf, alibi_a(lane, 16), qbias);
                const int dbase = t - 31 - 16 * (ct * 32 + 4 * h);
                float y[16];
                if (ct >= ctmax - 1) tile_logits<16, 16, true>(y, s, slope2, -(1 << 30), dbase); else tile_logits<16, 16, false>(y, s, slope2, 0, 0);
                const float b0 = -slope2 * (float)(dbase + 64 * h);
                const float mt = pair_max(max16(y) + b0);
                if (__any(mt > m + 8.0f)) { const float mn = fmaxf(m, mt); l *= fast_exp2(m - mn); m = mn; }
                const float off = b0 - m; float ps = 0.f;
#pragma unroll
                for (int r = 0; r < 16; ++r) ps += fast_exp2(y[r] + off);
                l += ps;
                kc = kn;
            }
            l = pair_sum(l);
        }
        {
            const float il = l > 0.f ? fast_rcp(l) : 0.f;
            f32x16 o0 = zero16(), o1 = zero16();
            LAS float* impq = imp + (grp * 32 + qi) * IMP_PITCH;
            Frag4 kc = load_frag4(kcmp, ctmax, lane);
#pragma unroll 1
            for (int ct = ctmax; ct >= 0; --ct) {
                const Frag4 kn = load_frag4(kcmp, ct > 0 ? ct - 1 : 0, lane), vc = load_frag4(vcmp, ct, lane);
                const f32x16 s = qk_frag_b(kc, qf, alibi_a(lane, 16), qbias);
                const int dbase = t - 31 - 16 * (ct * 32 + 4 * h);
                float y[16];
                if (ct >= ctmax - 1) tile_logits<16, 16, true>(y, s, slope2, -(1 << 30), dbase); else tile_logits<16, 16, false>(y, s, slope2, 0, 0);
                const float off = -slope2 * (float)(dbase + 64 * h) - m;
                float pr[16];
#pragma unroll
                for (int r = 0; r < 16; ++r) pr[r] = fast_exp2(y[r] + off) * il;
                pv_frag(o0, o1, vc, pr);
#pragma unroll
                for (int i = 0; i < 4; ++i) { const int jb = ct * 8 + 2 * i + h;
                    float gs = (pr[4 * i] + pr[4 * i + 1]) + (pr[4 * i + 2] + pr[4 * i + 3]), g3 = pr[4 * i + 3];
                    gs += dpp_f<0xB1>(gs); gs += dpp_f<0x4E>(gs); g3 += dpp_f<0xB1>(g3); g3 += dpp_f<0x4E>(g3);
                    if ((col & 3) == 0) { impq[jb] += gs; if (jb + 1 < 256) impq[jb + 1] += g3; } }
                kc = kn;
            }
            ob0 = o0 * g0; ob1 = o1 * g0;
        }
        __syncthreads();
        {
            const int sg = lane >> 5, sq = lane & 31, st = qt * 32 + sq, tb = st >> 6;
            const int tbmax = (qt * 32 + 31) >> 6;
            LAS const float* ip = imp + (sg * 32 + sq) * IMP_PITCH;
            unsigned lst[16];
#pragma unroll
            for (int i = 0; i < 16; ++i) lst[i] = 0u;
            const int jb_hi = (32 * wid + 31 < tbmax) ? 32 * wid + 31 : tbmax;
#pragma unroll 1
            for (int jb = 32 * wid; jb <= jb_hi; ++jb) {
                const float v = ip[jb];
                unsigned key = (__float_as_uint(v) & 0xffffff00u) | (unsigned)(255 - jb);
                if (jb == 0 || jb == tb || jb == tb - 1) key = 0xffffff00u | (unsigned)(255 - jb);
                if (jb > tb) key = 0u;
                top16_insert(lst, key);
            }
#pragma unroll
            for (int rd = 4; rd >= 1; rd >>= 1) {
                if (wid >= rd && wid < 2 * rd) {
#pragma unroll
                    for (int i = 0; i < 16; ++i) lists[(wid * 64 + lane) * 16 + i] = lst[i]; }
                __syncthreads();
                if (wid < rd) {
#pragma unroll 1
                    for (int i = 0; i < 16; ++i) top16_insert(lst, lists[((wid + rd) * 64 + lane) * 16 + i]); }
            }
            if (wid == 0) {
                unsigned wds[8];
#pragma unroll
                for (int w = 0; w < 8; ++w) wds[w] = 0u;
#pragma unroll
                for (int i = 0; i < 16; ++i) { const unsigned jb = 255u - (lst[i] & 255u); const unsigned bit = lst[i] ? (1u << (jb & 31u)) : 0u;
#pragma unroll
                    for (int w = 0; w < 8; ++w) wds[w] |= ((jb >> 5) == (unsigned)w) ? bit : 0u; }
                LAS unsigned* sp = sel + (sg * 32 + sq) * 8;
#pragma unroll
                for (int w = 0; w < 8; ++w) {
                    sp[w] = wds[w];
                    unsigned u = wds[w];
                    u |= dpp_u<0xB1>(u); u |= dpp_u<0x4E>(u); u |= dpp_u<0x141>(u); u |= dpp_u<0x140>(u);
                    const unsigned u0 = (unsigned)__builtin_amdgcn_readlane((int)u, 0) | (unsigned)__builtin_amdgcn_readlane((int)u, 16);
                    const unsigned u1 = (unsigned)__builtin_amdgcn_readlane((int)u, 32) | (unsigned)__builtin_amdgcn_readlane((int)u, 48);
                    if (lane == 0) { selu[w] = u0; selu[8 + w] = u1; }
                }
            }
        }
        __syncthreads();
        {
            Acc2 a; a.o0 = zero16(); a.o1 = zero16(); a.m = -1e4f; a.l = 0.f;
            LAS const unsigned* sp = sel + (grp * 32 + qi) * 8;
            LAS const unsigned* up = selu + grp * 8;
            int w = 7; unsigned bits = (unsigned)__builtin_amdgcn_readfirstlane((int)up[7]);
            while (bits == 0u && w > 0) { --w; bits = (unsigned)__builtin_amdgcn_readfirstlane((int)up[w]); }
            int jb = w * 32 + 31 - __builtin_clz(bits); bits &= ~(1u << (jb & 31));
            int kt = 2 * jb + 1;
            Frag4 kc = load_frag4(kslc, kt, lane);
            const int tb_lo = (qt * 32) >> 6;
            bool more = true;
#pragma unroll 1
            while (more) {
                int ktn = kt - 1, jbn = jb;
                if (!(kt & 1)) {
                    while (bits == 0u && w > 0) { --w; bits = (unsigned)__builtin_amdgcn_readfirstlane((int)up[w]); }
                    if (bits != 0u) { jbn = w * 32 + 31 - __builtin_clz(bits); bits &= ~(1u << (jbn & 31)); ktn = 2 * jbn + 1; }
                    else { more = false; ktn = kt; }
                }
                const Frag4 kn = load_frag4(kslc, ktn, lane), vc = load_frag4(vslc, kt, lane);
                const bool mine = (sp[jb >> 5] >> (jb & 31)) & 1u;
                const f32x16 s = qk_frag_b(kc, qf, alibi_a(lane, 1), qbias);
                const int dbase = t - (kt * 32 + 4 * h);
                float y[16];
                if (jb >= tb_lo) tile_logits<1, 1, true>(y, s, slope2, -(1 << 30), dbase); else tile_logits<1, 1, false>(y, s, slope2, 0, 0);
                sm_step(a, y, mine ? -slope2 * (float)(dbase + 4 * h) : NEGV, vc);
                kc = kn; kt = ktn; jb = jbn;
            }
            const float sc = g1 * fast_rcp(pair_sum(a.l));
            ob0 += a.o0 * sc; ob1 += a.o1 * sc;
        }
        {
            Acc2 a; a.o0 = zero16(); a.o1 = zero16(); a.m = -1e4f; a.l = 0.f;
            banded_loop<512, false>(a, qf, alibi_a(lane, 1), qbias, slope2, t, h, kwin, vwin, qt, qt - 16 < 0 ? 0 : qt - 16, lane);
            const float sc = g2 * fast_rcp(pair_sum(a.l));
            ob0 += a.o0 * sc; ob1 += a.o1 * sc;
        }
        {
            constexpr int OP = 528;
            LAS unsigned char* stg = lds + wid * (8 * OP);
            LAS unsigned char* wp = stg + (col >> 2) * OP + (col & 3) * 128 + 8 * h;
#pragma unroll
            for (int i = 0; i < 4; ++i) {
                u32x2 w; w.x = cvt_pk_bf16(ob0[4 * i], ob0[4 * i + 1]); w.y = cvt_pk_bf16(ob0[4 * i + 2], ob0[4 * i + 3]);
                *(LAS u32x2*)(wp + 16 * i) = w;
                u32x2 z; z.x = cvt_pk_bf16(ob1[4 * i], ob1[4 * i + 1]); z.y = cvt_pk_bf16(ob1[4 * i + 2], ob1[4 * i + 3]);
                *(LAS u32x2*)(wp + 64 + 16 * i) = z;
            }
            __builtin_amdgcn_wave_barrier();
            bf16_t* ob = (bf16_t*)(p.ws + OFF_OB) + (size_t)(qt * 32 + 8 * (wid & 3)) * 512 + grp * 256 + 8 * (lane & 31);
#pragma unroll
            for (int j = 0; j < 4; ++j) { const int qw = (lane >> 5) + 2 * j;
                const u32x4 v = *(LAS const u32x4*)(stg + qw * OP + 16 * (lane & 31));
                *(u32x4*)(ob + (size_t)qw * 512) = v; }
            __builtin_amdgcn_wave_barrier();
        }
    }
}

__device__ __forceinline__ void peer_half_top16(const bf16_t* qr, const bf16_t* kp, int t0, int hd, int half, int lane, unsigned (&lst)[16]) {
    const int h = lane >> 5, tl = lane & 31;
    f32x16 sT[4];
#pragma unroll
    for (int nt = 0; nt < 4; ++nt) sT[nt] = zero16();
    const bf16_t* qb = qr + (size_t)(t0 + tl) * 2048 + hd * 256 + half * 128 + 8 * h;
    const bf16_t* kb = kp + ((size_t)(half * 8 + hd) * 128 + tl) * 128 + 8 * h;
#pragma unroll 2
    for (int ks = 0; ks < 8; ++ks) {
        const bf16x8 b = *(const bf16x8*)(qb + 16 * ks);
#pragma unroll
        for (int nt = 0; nt < 4; ++nt) { const bf16x8 a = *(const bf16x8*)(kb + (size_t)nt * 32 * 128 + 16 * ks); sT[nt] = MFMA32(a, b, sT[nt]); }
    }
#pragma unroll
    for (int i = 0; i < 16; ++i) lst[i] = 0u;
#pragma unroll
    for (int nt = 0; nt < 4; ++nt)
#pragma unroll
        for (int r = 0; r < 16; ++r) { const unsigned n = (unsigned)(nt * 32 + ROWOFF(r) + 4 * h); top16_insert(lst, (f2ord(sT[nt][r]) & 0xffffff80u) | n); }
    unsigned oth[16];
#pragma unroll
    for (int i = 0; i < 16; ++i) oth[i] = (unsigned)__shfl_xor((int)lst[i], 32);
#pragma unroll
    for (int i = 0; i < 16; ++i) top16_insert(lst, oth[i]);
}

#define PK_CE(x_, i_, j_) do { const float hi_ = __builtin_amdgcn_fmed3f(x_[i_], x_[j_], __builtin_inff()), lo_ = __builtin_amdgcn_fmed3f(x_[i_], x_[j_], -__builtin_inff()); x_[i_] = hi_; x_[j_] = lo_; } while (0)
__device__ __forceinline__ void sort16_desc(float (&x)[16]) {
    PK_CE(x, 0, 1); PK_CE(x, 2, 3); PK_CE(x, 0, 2); PK_CE(x, 1, 3); PK_CE(x, 1, 2); PK_CE(x, 4, 5); PK_CE(x, 6, 7); PK_CE(x, 4, 6);
    PK_CE(x, 5, 7); PK_CE(x, 5, 6); PK_CE(x, 0, 4); PK_CE(x, 2, 6); PK_CE(x, 2, 4); PK_CE(x, 1, 5); PK_CE(x, 3, 7); PK_CE(x, 3, 5);
    PK_CE(x, 1, 2); PK_CE(x, 3, 4); PK_CE(x, 5, 6); PK_CE(x, 8, 9); PK_CE(x, 10, 11); PK_CE(x, 8, 10); PK_CE(x, 9, 11); PK_CE(x, 9, 10);
    PK_CE(x, 12, 13); PK_CE(x, 14, 15); PK_CE(x, 12, 14); PK_CE(x, 13, 15); PK_CE(x, 13, 14); PK_CE(x, 8, 12); PK_CE(x, 10, 14); PK_CE(x, 10, 12);
    PK_CE(x, 9, 13); PK_CE(x, 11, 15); PK_CE(x, 11, 13); PK_CE(x, 9, 10); PK_CE(x, 11, 12); PK_CE(x, 13, 14); PK_CE(x, 0, 8); PK_CE(x, 4, 12);
    PK_CE(x, 4, 8); PK_CE(x, 2, 10); PK_CE(x, 6, 14); PK_CE(x, 6, 10); PK_CE(x, 2, 4); PK_CE(x, 6, 8); PK_CE(x, 10, 12); PK_CE(x, 1, 9);
    PK_CE(x, 5, 13); PK_CE(x, 5, 9); PK_CE(x, 3, 11); PK_CE(x, 7, 15); PK_CE(x, 7, 11); PK_CE(x, 3, 5); PK_CE(x, 7, 9); PK_CE(x, 11, 13);
    PK_CE(x, 1, 2); PK_CE(x, 3, 4); PK_CE(x, 5, 6); PK_CE(x, 7, 8); PK_CE(x, 9, 10); PK_CE(x, 11, 12); PK_CE(x, 13, 14);
    __builtin_amdgcn_sched_barrier(0);
}
__device__ __forceinline__ void merge16_top(float (&a)[16], const float (&b)[16]) {
#pragma unroll
    for (int i = 0; i < 16; ++i) a[i] = __builtin_amdgcn_fmed3f(a[i], b[15 - i], __builtin_inff());
    PK_CE(a, 0, 8); PK_CE(a, 1, 9); PK_CE(a, 2, 10); PK_CE(a, 3, 11); PK_CE(a, 4, 12); PK_CE(a, 5, 13); PK_CE(a, 6, 14); PK_CE(a, 7, 15);
    PK_CE(a, 0, 4); PK_CE(a, 1, 5); PK_CE(a, 2, 6); PK_CE(a, 3, 7); PK_CE(a, 8, 12); PK_CE(a, 9, 13); PK_CE(a, 10, 14); PK_CE(a, 11, 15);
    PK_CE(a, 0, 2); PK_CE(a, 1, 3); PK_CE(a, 4, 6); PK_CE(a, 5, 7); PK_CE(a, 8, 10); PK_CE(a, 9, 11); PK_CE(a, 12, 14); PK_CE(a, 13, 15);
    PK_CE(a, 0, 1); PK_CE(a, 2, 3); PK_CE(a, 4, 5); PK_CE(a, 6, 7); PK_CE(a, 8, 9); PK_CE(a, 10, 11); PK_CE(a, 12, 13); PK_CE(a, 14, 15);
    __builtin_amdgcn_sched_barrier(0);
}
__device__ __forceinline__ void top16_insert_f(float (&l)[16], float k) {
    float n[16];
    n[0] = __builtin_amdgcn_fmed3f(l[0], k, __builtin_inff());
#pragma unroll
    for (int i = 1; i < 16; ++i) n[i] = __builtin_amdgcn_fmed3f(l[i - 1], l[i], k);
#pragma unroll
    for (int i = 0; i < 16; ++i) l[i] = n[i];
    __builtin_amdgcn_sched_barrier(0);
}
__device__ __forceinline__ void peer_topk_tail_f(const float (&l1)[16], const float (&l2)[16], int t0, int hd, int lane, int* ids, float* gates, LAS unsigned* tab) {
    float v1[16], v2[16];
#pragma unroll
    for (int i = 0; i < 16; ++i) { const unsigned b1 = __float_as_uint(l1[i]), b2 = __float_as_uint(l2[i]);
        v1[i] = __uint_as_float(b1 & 0xffffff80u); v2[i] = __uint_as_float(b2 & 0xffffff80u);
        tab[i * 64 + lane] = b1 & 127u; tab[(16 + i) * 64 + lane] = b2 & 127u; }
    float cl[16];
#pragma unroll
    for (int i = 0; i < 16; ++i) cl[i] = -__builtin_inff();
#pragma unroll
    for (int a = 0; a < 16; ++a)
#pragma unroll
        for (int b = 0; b < 16; ++b)
            if ((a + 1) * (b + 1) <= 16) top16_insert_f(cl, __uint_as_float((__float_as_uint(v1[a] + v2[b]) & 0xffffff00u) | (unsigned)(a * 16 + b)));
    float sc[16]; int e[16];
#pragma unroll
    for (int k = 0; k < 16; ++k) {
        const unsigned c = __float_as_uint(cl[k]);
        sc[k] = __uint_as_float(c & 0xffffff00u);
        const unsigned i1 = tab[((c >> 4) & 15u) * 64 + lane], i2 = tab[(16u + (c & 15u)) * 64 + lane];
        e[k] = (int)(i1 * 128u + i2);
    }
    float den = 0.f, g[16];
#pragma unroll
    for (int k = 0; k < 16; ++k) { g[k] = fast_exp(sc[k] - sc[0]); den += g[k]; }
    const float inv = fast_rcp(den);
    if (lane < 32) {
        int4* ip = (int4*)(ids + (size_t)(t0 + lane) * 128 + hd * 16);
        float4* gp = (float4*)(gates + (size_t)(t0 + lane) * 128 + hd * 16);
#pragma unroll
        for (int q = 0; q < 4; ++q) { ip[q] = make_int4(e[4 * q], e[4 * q + 1], e[4 * q + 2], e[4 * q + 3]);
            gp[q] = make_float4(g[4 * q] * inv, g[4 * q + 1] * inv, g[4 * q + 2] * inv, g[4 * q + 3] * inv); }
    }
}
constexpr int QT_PITCH = 528;
__device__ __forceinline__ void peer_half_top16_lds(LAS const unsigned char* qtile, const bf16_t* kp, int w, int hd, int half, int lane, float (&lst)[16]) {
    int h = lane >> 5; const int tl = lane & 31;
    asm volatile("" : "+v"(h));
    const unsigned h4 = 4u * (unsigned)h;
    f32x16 sT[4];
#pragma unroll
    for (int nt = 0; nt < 4; ++nt) sT[nt] = zero16();
    LAS const unsigned char* qb = qtile + (32 * w + tl) * QT_PITCH + (half * 128 + 8 * h) * 2;
    const bf16_t* kb = kp + ((size_t)(half * 8 + hd) * 128 + tl) * 128 + 8 * h;
#pragma unroll 2
    for (int ks = 0; ks < 8; ++ks) {
        const bf16x8 b = *(LAS const bf16x8*)(qb + 32 * ks);
#pragma unroll
        for (int nt = 0; nt < 4; ++nt) { const bf16x8 a = *(const bf16x8*)(kb + (size_t)nt * 32 * 128 + 16 * ks); sT[nt] = MFMA32(a, b, sT[nt]); }
    }
    float g1[16], g2[16];
#pragma unroll
    for (int r = 0; r < 16; ++r) { lst[r] = __uint_as_float(((__float_as_uint(sT[0][r]) & 0xffffff80u) | (unsigned)(ROWOFF(r))) | h4);
        g1[r] = __uint_as_float(((__float_as_uint(sT[1][r]) & 0xffffff80u) | (unsigned)(32 + ROWOFF(r))) | h4); }
    sort16_desc(lst); sort16_desc(g1); merge16_top(lst, g1);
#pragma unroll
    for (int r = 0; r < 16; ++r) { g1[r] = __uint_as_float(((__float_as_uint(sT[2][r]) & 0xffffff80u) | (unsigned)(64 + ROWOFF(r))) | h4);
        g2[r] = __uint_as_float(((__float_as_uint(sT[3][r]) & 0xffffff80u) | (unsigned)(96 + ROWOFF(r))) | h4); }
    sort16_desc(g1); sort16_desc(g2); merge16_top(g1, g2);
    merge16_top(lst, g1);
#pragma unroll
    for (int i = 0; i < 16; ++i) g1[i] = __shfl_xor(lst[i], 32);
    merge16_top(lst, g1);
}
struct EpiQrTopk {
    static constexpr bool PERM = true, AFTER_DRAIN = true;
    const float* rowss; const bf16_t* kp; int* ids; float* gates;
    __device__ __forceinline__ void operator()(const f32x4 (&)[2][2][4][2], const pg8::Unit&, int, int, int, int) const {}
    __device__ __forceinline__ void fused(const f32x4 (&acc)[2][2][4][2], const pg8::Unit& u, int wr, int wc, int fr, int fq, LAS unsigned char* lds, int wid, int lane) const {
        __builtin_amdgcn_sched_barrier(0); asm volatile("s_nop 15\n\ts_nop 15" ::: "memory"); __builtin_amdgcn_sched_barrier(0);
#pragma unroll
        for (int ai = 0; ai < 2; ++ai)
#pragma unroll
            for (int m = 0; m < 4; ++m) { const int rl = ai * 128 + wr * 64 + m * 16 + fr; const float rs = row_rstd(rowss, u.pm * 256 + rl) * (1.0f / (WG_SCALE * X8_SCALE));
#pragma unroll
                for (int bj = 0; bj < 2; ++bj) { const int cl = bj * 128 + wc * 32 + 8 * fq;
                    const f32x4 v0 = acc[ai][bj][m][0] * rs, v1 = acc[ai][bj][m][1] * rs;
                    *(LAS u32x4*)(lds + rl * QT_PITCH + cl * 2) = pack_acc(v0, v1); }
                __builtin_amdgcn_sched_barrier(0); }
        __syncthreads();
        float l1[16], l2[16];
        peer_half_top16_lds(lds, kp, wid, u.pn, 0, lane, l1);
        peer_half_top16_lds(lds, kp, wid, u.pn, 1, lane, l2);
        __builtin_amdgcn_wave_barrier();
        peer_topk_tail_f(l1, l2, u.pm * 256 + 32 * wid, u.pn, lane, ids, gates, (LAS unsigned*)(lds + (32 * wid) * QT_PITCH));
        __syncthreads();
    }
};
struct OneUnit {
    pg8::Unit u;
    __device__ __forceinline__ bool next(int i, pg8::Unit& o) const { if (i != 0) return false; o = u; return true; }
    __device__ __forceinline__ void a_ready(const pg8::Unit&) const {}
    __device__ __forceinline__ void done(const pg8::Unit&) const {}
};

__device__ __forceinline__ float dot16_fp4(const u32x2& w, const float (&x)[16]) {
    float s0 = 0.f, s1 = 0.f;
#pragma unroll
    for (int q = 0; q < 2; ++q) {
        const f32x2_t v0 = __builtin_amdgcn_cvt_scalef32_pk_f32_fp4(w[q], 1.0f, 0), v1 = __builtin_amdgcn_cvt_scalef32_pk_f32_fp4(w[q], 1.0f, 1);
        const f32x2_t v2 = __builtin_amdgcn_cvt_scalef32_pk_f32_fp4(w[q], 1.0f, 2), v3 = __builtin_amdgcn_cvt_scalef32_pk_f32_fp4(w[q], 1.0f, 3);
        s0 += v0[0] * x[8 * q] + v1[0] * x[8 * q + 2] + v2[0] * x[8 * q + 4] + v3[0] * x[8 * q + 6];
        s1 += v0[1] * x[8 * q + 1] + v1[1] * x[8 * q + 3] + v2[1] * x[8 * q + 5] + v3[1] * x[8 * q + 7];
    }
    return s0 + s1;
}
__device__ __forceinline__ void wave_sum8(float (&r)[8], const float (&d)[8]) {
    float a[4], b2[2];
#pragma unroll
    for (int k = 0; k < 4; ++k) { const auto s = __builtin_amdgcn_permlane32_swap(__float_as_uint(d[k]), __float_as_uint(d[k + 4]), false, false); a[k] = __uint_as_float(s[0]) + __uint_as_float(s[1]); }
#pragma unroll
    for (int k = 0; k < 2; ++k) { const auto s = __builtin_amdgcn_permlane16_swap(__float_as_uint(a[k]), __float_as_uint(a[k + 2]), false, false); b2[k] = __uint_as_float(s[0]) + __uint_as_float(s[1]); }
    float c0 = b2[0], c1 = b2[1];
    c0 += dpp_f<0xB1>(c0); c0 += dpp_f<0x4E>(c0); c0 += dpp_f<0x141>(c0); c0 += dpp_f<0x140>(c0);
    c1 += dpp_f<0xB1>(c1); c1 += dpp_f<0x4E>(c1); c1 += dpp_f<0x141>(c1); c1 += dpp_f<0x140>(c1);
    r[0] = __int_as_float(__builtin_amdgcn_readlane(__float_as_int(c0), 0));  r[1] = __int_as_float(__builtin_amdgcn_readlane(__float_as_int(c1), 0));
    r[2] = __int_as_float(__builtin_amdgcn_readlane(__float_as_int(c0), 16)); r[3] = __int_as_float(__builtin_amdgcn_readlane(__float_as_int(c1), 16));
    r[4] = __int_as_float(__builtin_amdgcn_readlane(__float_as_int(c0), 32)); r[5] = __int_as_float(__builtin_amdgcn_readlane(__float_as_int(c1), 32));
    r[6] = __int_as_float(__builtin_amdgcn_readlane(__float_as_int(c0), 48)); r[7] = __int_as_float(__builtin_amdgcn_readlane(__float_as_int(c1), 48));
}
__device__ __forceinline__ void axpy16_fp4(float (&o)[16], float a, const u32x2& w) {
#pragma unroll
    for (int q = 0; q < 2; ++q) {
        const f32x2_t v0 = __builtin_amdgcn_cvt_scalef32_pk_f32_fp4(w[q], 1.0f, 0), v1 = __builtin_amdgcn_cvt_scalef32_pk_f32_fp4(w[q], 1.0f, 1);
        const f32x2_t v2 = __builtin_amdgcn_cvt_scalef32_pk_f32_fp4(w[q], 1.0f, 2), v3 = __builtin_amdgcn_cvt_scalef32_pk_f32_fp4(w[q], 1.0f, 3);
        o[8 * q] += a * v0[0]; o[8 * q + 1] += a * v0[1]; o[8 * q + 2] += a * v1[0]; o[8 * q + 3] += a * v1[1];
        o[8 * q + 4] += a * v2[0]; o[8 * q + 5] += a * v2[1]; o[8 * q + 6] += a * v3[0]; o[8 * q + 7] += a * v3[1];
    }
}
typedef int i32x8 __attribute__((ext_vector_type(8)));
constexpr int PG_TOK = 8;
constexpr int PG_STG = 69632;
constexpr int PG_COEF = PG_TOK * 512, PG_WAVE = PG_COEF + 4096, PG_ZERO = 8 * PG_WAVE;
typedef int i32x4 __attribute__((ext_vector_type(4)));
__device__ __forceinline__ f32x4 pg_mfma(const u32x4& a, const i32x8& b, const f32x4& c) {
    const i32x4 a4 = __builtin_bit_cast(i32x4, a);
    return __builtin_amdgcn_mfma_scale_f32_16x16x128_f8f6f4(__builtin_shufflevector(a4, a4, 0, 1, 2, 3, -1, -1, -1, -1), b, c, 4, 0, 0, 0x7F7F7F7F, 0, 0x7F7F7F7F);
}
__device__ __forceinline__ void phase_peer_gather(const Params& p, LAS unsigned char* lds, int layer, int wv, int tfirst, int tstride, int tend) {
    const int tid = opaque_tid(wv), lane = tid & 63, wid = wv;
    const int r16 = lane & 15, g = lane >> 4;
    const int gw = tfirst + wid, nw = tstride;
    const unsigned char* U = p.ws + OFF_U + (size_t)layer * 16384 * 512; const unsigned char* V = p.ws + OFF_V + (size_t)layer * 16384 * 512;
    const int* ids = (const int*)(p.ws + OFF_PIDS); const float* gates = (const float*)(p.ws + OFF_PGT);
    const bf16_t* x1b = (const bf16_t*)(p.ws + OFF_H); bf16_t* xnew = (bf16_t*)(p.ws + OFF_XS); const float* rowss = (const float*)(p.ws + OFF_ROWSS);
    const float* g2 = p.norm2 + layer * DM;
    const float* gn = (layer + 1 < NLAYER) ? p.norm1 + (layer + 1) * DM : p.norm_f;
    LAS unsigned char* wl = lds + wid * PG_WAVE;
    { unsigned z0 = 0u; asm volatile("" : "+v"(z0));
      if (tid < 64) ((LAS u32x4*)(lds + PG_ZERO))[tid] = (u32x4){z0, z0, z0, z0}; }
    __syncthreads();
    LAS unsigned char* wh = wl + PG_COEF;
    LAS const unsigned char* bsrc = (r16 < 4 ? wh + 1024 * (r16 & 1) + 128 * (r16 >> 1) : lds + PG_ZERO) + 16 * g;
    LAS float* coef0 = (LAS float*)wl;
#define PG_LD(T_, base_, off_) (*(const T_*)((const unsigned char*)(base_) + (off_)))
#define PG_OFFS unsigned l64 = 64u * (unsigned)lane, l8 = 8u * (unsigned)lane, l4 = 4u * (unsigned)lane, g16 = 16u * (unsigned)g, r4 = 4u * (unsigned)r16; \
                asm volatile("" : "+v"(l64), "+v"(l8), "+v"(l4), "+v"(g16), "+v"(r4));
    for (int tc = gw; tc < tend; tc += PG_TOK * nw) {
        const int left = (tend - tc + nw - 1) / nw, nt = left < PG_TOK ? left : PG_TOK;
        {
            const int er = r16 >> 1;
            u32x4 P0[4], P1[4], P2[4], P3[4];
            f32x4 gq[4]; u32x4 xa[2]; float rs;
#define PG_ULOAD(P_, id_) do { const unsigned o_ = (unsigned)(id_) * 512u + hoff; _Pragma("unroll") for (int s = 0; s < 4; ++s) P_[s] = *(const u32x4*)(U + o_ + 128 * s); } while (0)
            {   PG_OFFS
                const unsigned hoff = 64u * (unsigned)(r16 & 1) + g16, e4 = 4u * (unsigned)er;
                const int* idp = ids + (size_t)tc * 128;
                const int i0 = PG_LD(int, idp, e4), i1 = PG_LD(int, idp + 8, e4), i2 = PG_LD(int, idp + 16, e4), i3 = PG_LD(int, idp + 24, e4);
                PG_ULOAD(P0, i0); PG_ULOAD(P1, i1); PG_ULOAD(P2, i2); PG_ULOAD(P3, i3);
#pragma unroll
                for (int q = 0; q < 4; ++q) gq[q] = PG_LD(f32x4, g2 + 4 * q, l64);
                xa[0] = PG_LD(u32x4, x1b + (size_t)tc * DM, l64 >> 1); xa[1] = PG_LD(u32x4, x1b + (size_t)tc * DM + 8, l64 >> 1);
                rs = row_rstd(rowss, tc);
            }
#pragma unroll 1
            for (int i = 0; i < nt; ++i) {
                const int t = tc + i * nw, tn = i + 1 < nt ? t + nw : t;
                PG_OFFS
                unsigned hoff = 64u * (unsigned)(r16 & 1) + g16, e4 = 4u * (unsigned)er, g8 = 8u * (unsigned)g;
                asm volatile("" : "+v"(hoff), "+v"(e4), "+v"(g8));
                const int* idp = ids + (size_t)t * 128; const int* idn = ids + (size_t)tn * 128;
                int raw[16];
#pragma unroll
                for (int b = 0; b < 12; ++b) raw[b] = PG_LD(int, idp + 8 * (b + 4), e4);
#pragma unroll
                for (int b = 0; b < 4; ++b) raw[12 + b] = PG_LD(int, idn + 8 * b, e4);
                {
                    u32x4 hw, lw;
#pragma unroll
                    for (int q = 0; q < 4; ++q) { const unsigned wa = xa[q >> 1][2 * (q & 1)], wb = xa[q >> 1][2 * (q & 1) + 1]; const f32x4 a = {bf_lo(wa), bf_hi(wa), bf_lo(wb), bf_hi(wb)}, gg = gq[q];
                        const float h0 = a[0] * gg[0] * rs, h1 = a[1] * gg[1] * rs, h2 = a[2] * gg[2] * rs, h3 = a[3] * gg[3] * rs;
                        int w = 0; w = __builtin_amdgcn_cvt_pk_fp8_f32(h0, h1, w, false); w = __builtin_amdgcn_cvt_pk_fp8_f32(h2, h3, w, true);
                        const float d0 = (h0 - __builtin_amdgcn_cvt_f32_fp8(w, 0)) * 64.0f, d1 = (h1 - __builtin_amdgcn_cvt_f32_fp8(w, 1)) * 64.0f;
                        const float d2 = (h2 - __builtin_amdgcn_cvt_f32_fp8(w, 2)) * 64.0f, d3 = (h3 - __builtin_amdgcn_cvt_f32_fp8(w, 3)) * 64.0f;
                        int v = 0; v = __builtin_amdgcn_cvt_pk_fp8_f32(d0, d1, v, false); v = __builtin_amdgcn_cvt_pk_fp8_f32(d2, d3, v, true);
                        hw[q] = (unsigned)w; lw[q] = (unsigned)v; }
                    *(LAS u32x4*)(wh + 16 * lane) = hw; *(LAS u32x4*)(wh + 1024 + 16 * lane) = lw;
                    xa[0] = PG_LD(u32x4, x1b + (size_t)tn * DM, l64 >> 1); xa[1] = PG_LD(u32x4, x1b + (size_t)tn * DM + 8, l64 >> 1);
                    rs = row_rstd(rowss, tn);
                }
                __builtin_amdgcn_wave_barrier();
                i32x8 B[4];
#pragma unroll
                for (int s = 0; s < 4; ++s) { const u32x4 b0 = *(LAS const u32x4*)(bsrc + 256 * s), b1 = *(LAS const u32x4*)(bsrc + 256 * s + 64);
                    B[s] = (i32x8){(int)b0[0], (int)b0[1], (int)b0[2], (int)b0[3], (int)b1[0], (int)b1[1], (int)b1[2], (int)b1[3]}; }
                __builtin_amdgcn_sched_barrier(0);
                LAS float* coef = coef0 + i * 128;
                const float sc = (r16 & 1) ? (1.0f / (64.0f * U4_SCALE)) : (1.0f / U4_SCALE);
                const bool first = r16 < 2;
#define PG_UBLOCK(P_, b_) do { \
                    const f32x2_t gt_ = PG_LD(f32x2_t, gates + (size_t)t * 128 + 8 * (b_), g8); \
                    f32x4 acc_ = {0.f, 0.f, 0.f, 0.f}; \
                    _Pragma("unroll") for (int s = 0; s < 4; ++s) acc_ = pg_mfma(P_[s], B[s], acc_); \
                    PG_ULOAD(P_, raw[(b_) - 0]); \
                    float va_ = (first ? acc_[0] : acc_[1]) * sc, vb_ = (first ? acc_[2] : acc_[3]) * sc; \
                    va_ += dpp_f<0xB1>(va_); vb_ += dpp_f<0xB1>(vb_); va_ += dpp_f<0x4E>(va_); vb_ += dpp_f<0x4E>(vb_); \
                    f32x2_t cf_ = {gelu_tanh(va_) * gt_[0], gelu_tanh(vb_) * gt_[1]}; \
                    asm volatile("" : "+v"(cf_)); \
                    if (r16 == 0) *(LAS f32x2_t*)(coef + 8 * (b_) + 2 * g) = cf_; \
                    __builtin_amdgcn_sched_barrier(0); } while (0)
                PG_UBLOCK(P0, 0); PG_UBLOCK(P1, 1); PG_UBLOCK(P2, 2); PG_UBLOCK(P3, 3);
                PG_UBLOCK(P0, 4); PG_UBLOCK(P1, 5); PG_UBLOCK(P2, 6); PG_UBLOCK(P3, 7);
                PG_UBLOCK(P0, 8); PG_UBLOCK(P1, 9); PG_UBLOCK(P2, 10); PG_UBLOCK(P3, 11);
                PG_UBLOCK(P0, 12); PG_UBLOCK(P1, 13); PG_UBLOCK(P2, 14); PG_UBLOCK(P3, 15);
            }
        }
        __builtin_amdgcn_wave_barrier();
        {
            int idA, idB;
            u32x2 vr0[8], vr1[8];
#define PG_VBATCH(vr_, b_) do { const f32x4 c0_ = *(LAS const f32x4*)(coef + 8 * (b_)), c1_ = *(LAS const f32x4*)(coef + 8 * (b_) + 4); \
            _Pragma("unroll") for (int k = 0; k < 8; ++k) { axpy16_fp4(o, k < 4 ? c0_[k & 3] : c1_[k & 3], vr_[k]); __builtin_amdgcn_sched_barrier(0); } } while (0)
#define PG_VLOAD(vr_, ida_, idb_, b_) do { const int idr_ = (b_) < 8 ? ida_ : idb_; const int l_ = (8 * (b_)) & 63; \
            _Pragma("unroll") for (int k = 0; k < 8; ++k) { const int e = __builtin_amdgcn_readlane(idr_, l_ + k); vr_[k] = PG_LD(u32x2, V + (size_t)(unsigned)e * 512u, l8); } \
            __builtin_amdgcn_sched_barrier(0); } while (0)
            {   PG_OFFS
                const int* idp = ids + (size_t)tc * 128;
                idA = PG_LD(int, idp, l4); idB = PG_LD(int, idp + 64, l4);
                PG_VLOAD(vr0, idA, idB, 0); PG_VLOAD(vr1, idA, idB, 1);
            }
#pragma unroll 1
            for (int i = 0; i < nt; ++i) {
                const int t = tc + i * nw, tn = i + 1 < nt ? t + nw : t;
                PG_OFFS
                const bf16_t* xr = x1b + (size_t)t * DM;
                const int* idn = ids + (size_t)tn * 128;
                const int nidA = PG_LD(int, idn, l4), nidB = PG_LD(int, idn + 64, l4);
                LAS const float* coef = coef0 + i * 128;
                if (layer + 1 < NLAYER) {
                    const bool isv = t >= 8192; const int tt = isv ? t - 8192 : t;
                    const unsigned char* cs = (const unsigned char*)((isv ? p.peer_v : p.peer_u) + (size_t)(layer + 1) * 16384 * 1024 + (size_t)tt * 2048);
#pragma unroll
                    for (int j = 0; j < 8; ++j) __builtin_amdgcn_global_load_lds((const unsigned*)(cs + 1024 * j + (l64 >> 2)), (LAS unsigned*)(lds + PG_STG + wid * 8192 + 1024 * j), 16, 0, 2);
                }
                float o[16];
#pragma unroll
                for (int k = 0; k < 16; ++k) o[k] = 0.f;
#pragma unroll 1
                for (int bb = 0; bb < 7; ++bb) {
                    PG_VBATCH(vr0, 2 * bb); PG_VLOAD(vr0, idA, idB, 2 * bb + 2);
                    PG_VBATCH(vr1, 2 * bb + 1); PG_VLOAD(vr1, idA, idB, 2 * bb + 3);
                }
                float x[16];
#pragma unroll
                for (int q = 0; q < 2; ++q) { const u32x4 a = PG_LD(u32x4, xr + 8 * q, l64 >> 1);
#pragma unroll
                    for (int e = 0; e < 4; ++e) { x[8 * q + 2 * e] = bf_lo(a[e]); x[8 * q + 2 * e + 1] = bf_hi(a[e]); } }
                __builtin_amdgcn_sched_barrier(0);
                PG_VBATCH(vr0, 14); PG_VLOAD(vr0, nidA, nidB, 0);
                PG_VBATCH(vr1, 15); PG_VLOAD(vr1, nidA, nidB, 1);
                idA = nidA; idB = nidB;
                float ss = 0.f;
#pragma unroll
                for (int k = 0; k < 16; ++k) { x[k] += o[k] * (1.0f / V4_SCALE); ss += x[k] * x[k]; }
                ss = wave_sum(ss);
                const float rn = rsqrtf(ss * (1.0f / DM) + RMS_EPS);
                float nx[16];
#pragma unroll
                for (int q = 0; q < 4; ++q) { const f32x4 gg = PG_LD(f32x4, gn + 4 * q, l64);
#pragma unroll
                    for (int e = 0; e < 4; ++e) nx[4 * q + e] = x[4 * q + e] * rn * gg[e]; }
#define PG_ROW_BF16(dst_, v_) do { u32x4 w0_, w1_; \
                    w0_.x = cvt_pk_bf16(v_[0], v_[1]); w0_.y = cvt_pk_bf16(v_[2], v_[3]); w0_.z = cvt_pk_bf16(v_[4], v_[5]); w0_.w = cvt_pk_bf16(v_[6], v_[7]); \
                    w1_.x = cvt_pk_bf16(v_[8], v_[9]); w1_.y = cvt_pk_bf16(v_[10], v_[11]); w1_.z = cvt_pk_bf16(v_[12], v_[13]); w1_.w = cvt_pk_bf16(v_[14], v_[15]); \
                    *(LAS u32x4*)(wh + 32 * lane) = w0_; *(LAS u32x4*)(wh + 32 * lane + 16) = w1_; \
                    __builtin_amdgcn_wave_barrier(); \
                    _Pragma("unroll") for (int j = 0; j < 2; ++j) { const u32x4 r_ = *(LAS const u32x4*)(wh + 16 * lane + 1024 * j); *(u32x4*)((unsigned char*)(dst_) + (l64 >> 2) + 1024 * j) = r_; } \
                    __builtin_amdgcn_wave_barrier(); } while (0)
                if (layer + 1 < NLAYER) {
                    PG_ROW_BF16(xnew + (size_t)t * DM, x);
                    PG_ROW_BF16((bf16_t*)(p.ws + OFF_H) + (size_t)t * DM, nx);
                    { u32x4 o8;
#pragma unroll
                      for (int i = 0; i < 4; ++i) { unsigned a = 0u; a = __builtin_amdgcn_cvt_pk_fp8_f32(nx[4 * i], nx[4 * i + 1], a, false); a = __builtin_amdgcn_cvt_pk_fp8_f32(nx[4 * i + 2], nx[4 * i + 3], a, true); o8[i] = a; }
                      *(u32x4*)(p.ws + OFF_H8 + (size_t)t * DM + (l64 >> 2)) = o8; }
                    {
                        asm volatile("s_waitcnt vmcnt(40)" ::: "memory");
                        const bool isv = t >= 8192; const int tt = isv ? t - 8192 : t;
                        unsigned char* cd = p.ws + (isv ? OFF_V : OFF_U) + (size_t)(layer + 1) * 16384 * 512 + (size_t)tt * 1024;
                        const float cscale = isv ? V4_SCALE : U4_SCALE;
                        unsigned lo_ = (unsigned)(lane >> 5) * 4096u + (unsigned)(lane & 31) * 32u, go_ = (unsigned)(lane >> 5) * 512u + (unsigned)(lane & 31) * 4u;
                        asm volatile("" : "+v"(lo_), "+v"(go_));
                        LAS const unsigned char* sg = lds + PG_STG + wid * 8192;
#pragma unroll 1
                        for (int jj = 0; jj < 4; ++jj) {
                            f32x4 a = *(LAS const f32x4*)(sg + lo_ + 1024 * jj), b = *(LAS const f32x4*)(sg + lo_ + 1024 * jj + 16);
#pragma unroll
                            for (int e = 0; e < 4; ++e) { a[e] = fminf(fmaxf(a[e] * cscale, -6.0f), 6.0f); b[e] = fminf(fmaxf(b[e] * cscale, -6.0f), 6.0f); }
                            unsigned pk = 0u;
                            pk = __builtin_amdgcn_cvt_scalef32_pk_fp4_f32(pk, a[0], a[1], 1.0f, 0);
                            pk = __builtin_amdgcn_cvt_scalef32_pk_fp4_f32(pk, a[2], a[3], 1.0f, 1);
                            pk = __builtin_amdgcn_cvt_scalef32_pk_fp4_f32(pk, b[0], b[1], 1.0f, 2);
                            pk = __builtin_amdgcn_cvt_scalef32_pk_fp4_f32(pk, b[2], b[3], 1.0f, 3);
                            __builtin_nontemporal_store(pk, (unsigned*)(cd + 128 * jj + go_));
                        }
                    }
                } else {
#pragma unroll
                    for (int q = 0; q < 4; ++q) *(LAS f32x4*)(wh + 64 * lane + 16 * q) = (f32x4){nx[4 * q], nx[4 * q + 1], nx[4 * q + 2], nx[4 * q + 3]};
                    __builtin_amdgcn_wave_barrier();
#pragma unroll
                    for (int j = 0; j < 4; ++j) { const f32x4 r = *(LAS const f32x4*)(wh + 16 * lane + 1024 * j); *(f32x4*)((unsigned char*)(p.out + (size_t)t * DM) + (l64 >> 2) + 1024 * j) = r; }
                    __builtin_amdgcn_wave_barrier();
                }
            }
        }
        __builtin_amdgcn_wave_barrier();
#ifdef PROBE_MASK
        {
            int idA, idB;
            u32x2 vr0[8], vr1[8];
#define PG_VLOADM(vr_, ida_, idb_, b_) do { const int idr_ = (b_) < 8 ? ida_ : idb_; const int l_ = (8 * (b_)) & 63; \
            _Pragma("unroll") for (int k = 0; k < 8; ++k) { const int e = __builtin_amdgcn_readlane(idr_, l_ + k) & PROBE_MASK; vr_[k] = PG_LD(u32x2, V + (size_t)(unsigned)e * 512u, l8); } \
            __builtin_amdgcn_sched_barrier(0); } while (0)
            {   PG_OFFS
                const int* idp = ids + (size_t)tc * 128;
                idA = PG_LD(int, idp, l4); idB = PG_LD(int, idp + 64, l4);
                PG_VLOADM(vr0, idA, idB, 0); PG_VLOADM(vr1, idA, idB, 1);
            }
#pragma unroll 1
            for (int i = 0; i < nt; ++i) {
                const int t = tc + i * nw, tn = i + 1 < nt ? t + nw : t;
                PG_OFFS
                const int* idn = ids + (size_t)tn * 128;
                const int nidA = PG_LD(int, idn, l4), nidB = PG_LD(int, idn + 64, l4);
                LAS const float* coef = coef0 + i * 128;
                float o[16];
#pragma unroll
                for (int k = 0; k < 16; ++k) o[k] = 0.f;
#pragma unroll 1
                for (int bb = 0; bb < 7; ++bb) {
                    PG_VBATCH(vr0, 2 * bb); PG_VLOADM(vr0, idA, idB, 2 * bb + 2);
                    PG_VBATCH(vr1, 2 * bb + 1); PG_VLOADM(vr1, idA, idB, 2 * bb + 3);
                }
                PG_VBATCH(vr0, 14); PG_VLOADM(vr0, nidA, nidB, 0);
                PG_VBATCH(vr1, 15); PG_VLOADM(vr1, nidA, nidB, 1);
                idA = nidA; idB = nidB;
                float* dump = (float*)((unsigned char*)((float*)(p.ws + OFF_QALL) + (size_t)t * DM) + l64);
#pragma unroll
                for (int q = 0; q < 4; ++q) *(f32x4*)(dump + 4 * q) = (f32x4){o[4 * q], o[4 * q + 1], o[4 * q + 2], o[4 * q + 3]};
            }
        }
        __builtin_amdgcn_wave_barrier();
#endif
    }
}

#define GAS __attribute__((address_space(1)))
struct ParamsG {
    const float GAS* x; const float GAS* norm1; const float GAS* w_in; const float GAS* sinks; const float GAS* cmp_pos; const float GAS* cmp_w1;
    const float GAS* cmp_w2; const float GAS* w_branch; const float GAS* w_out; const float GAS* norm2; const float GAS* peer_wq;
    const float GAS* peer_keys; const float GAS* peer_u; const float GAS* peer_v; const float GAS* norm_f;
    float GAS* out; unsigned char GAS* ws;
};
struct KP { Params v; __device__ __forceinline__ const Params& operator*() const { return v; } };
__device__ __forceinline__ KP kparams() {
    typedef const ParamsG __attribute__((address_space(4))) * KargPtr;
    KargPtr g = (KargPtr)__builtin_amdgcn_kernarg_segment_ptr(); asm volatile("" : "+s"(g));
    KP k;
    k.v.x = (const float*)g->x; k.v.norm1 = (const float*)g->norm1; k.v.w_in = (const float*)g->w_in; k.v.sinks = (const float*)g->sinks; k.v.cmp_pos = (const float*)g->cmp_pos;
    k.v.cmp_w1 = (const float*)g->cmp_w1; k.v.cmp_w2 = (const float*)g->cmp_w2; k.v.w_branch = (const float*)g->w_branch; k.v.w_out = (const float*)g->w_out; k.v.norm2 = (const float*)g->norm2;
    k.v.peer_wq = (const float*)g->peer_wq; k.v.peer_keys = (const float*)g->peer_keys; k.v.peer_u = (const float*)g->peer_u; k.v.peer_v = (const float*)g->peer_v; k.v.norm_f = (const float*)g->norm_f;
    k.v.out = (float*)g->out; k.v.ws = (unsigned char*)g->ws;
    return k;
}
#define PH_BEGIN const KP kp_ = kparams(); const Params& q = kp_.v; unsigned char* ws = q.ws; unsigned char* wl = ws + OFF_W + (size_t)layer * LW; const int G = gridDim.x, c = opaque_bid(); (void)wl; (void)G; (void)c;

struct TeamBranch {
    int pm, pn;
    __device__ __forceinline__ bool next(int i, pg8::Unit& u) const { if (i >= 3) return false; u.pm = pm + 64 * i; u.pn = pn + 4 * i; return true; }
    __device__ __forceinline__ void a_ready(const pg8::Unit&) const {}
    __device__ __forceinline__ void done(const pg8::Unit&) const {}
};
__device__ __forceinline__ void team_barrier(unsigned* ctr, unsigned target, unsigned* bar) {
    asm volatile("s_waitcnt vmcnt(0)" ::: "memory");
    __syncthreads();
    if (threadIdx.x == 0) { (void)xb_add(ctr, 1u); XB_SPIN(xb_ld(ctr) < target, bar); }
    __syncthreads();
}
template <int layer> __device__ __forceinline__ void layer_body(LAS unsigned char* lds, const int wv, const XcdBarrier& xb) {
        { PH_BEGIN
            pg8::Gemm g{(const bf16_t*)(ws + OFF_H), (const bf16_t*)(wl + W_IN), S_LEN, 2816, 1024}; pg8::StaticOrder S; S.init(S_LEN, 2816, G, c);
            EpiIn E{(bf16_t*)(ws + OFF_QALL), (bf16_t*)(ws + OFF_KALL), (bf16_t*)(ws + OFF_R)};
            pg8::gemm_phase<EpiIn, pg8::StaticOrder, true, true>(lds, g, S, E, wv);
        }
#define GATE_GEMM(Gv_, cv_, lim_) do { pg8::Gemm g{(const bf16_t*)(ws + OFF_H8), (const bf16_t*)(ws + OFF_WG8 + (size_t)layer * 3072 * 1024), S_LEN, 3072, 512}; \
            pg8::StaticOrder S; S.init(S_LEN, 3072, (Gv_), (cv_)); S.lim = (lim_); EpiGate E{ws + OFF_G8}; \
            pg8::gemm_phase<EpiGate, pg8::StaticOrder, true, true, true>(lds, g, S, E, wv); } while (0)
#define VT_GEMM(Gv_, cv_, lim_) do { pg8::Gemm g{(const bf16_t*)(wl + W_VT), (const bf16_t*)(ws + OFF_H), NVT, S_LEN, 1024}; \
            pg8::StaticOrder S; S.init(NVT, S_LEN, (Gv_), (cv_)); S.lim = (lim_); EpiVT E{(bf16_t*)(ws + OFF_VALL)}; \
            pg8::gemm_phase<EpiVT, pg8::StaticOrder, true, true>(lds, g, S, E, wv); } while (0)
        { PH_BEGIN
            const bool lightwg = (G == 256) && c >= 192;
            VT_GEMM(64, lightwg ? c - 192 : 0, lightwg ? 64 : 0);
        }
        xcd_barrier(xb);
        { PH_BEGIN phase2_compress(q, layer, lds, wv); }
        __syncthreads();
        { PH_BEGIN
            int gv = G, cv = c, lim = 256;
            if (G == 256) { if (c < 128) { gv = 128; cv = 64 + c; lim = 192; } else { gv = 64; cv = 192 + (c - 128); lim = c < 192 ? 256 : 0; } }
            VT_GEMM(gv, cv, lim);
        }
        { PH_BEGIN
            int gv = G, cv = c, lim = 768;
            if (G == 256) { if (c < 128) { gv = 128; lim = 256; } else if (c < 192) { gv = 64; cv = 256 + (c - 128); lim = 448; } else { gv = 64; cv = 448 + (c - 192); } }
            GATE_GEMM(gv, cv, lim);
        }
#undef GATE_GEMM
#undef VT_GEMM
        xcd_barrier(xb);
        {
#define TEAM_INFO const unsigned tw_ = (unsigned)__builtin_amdgcn_readfirstlane((int)((volatile LAS unsigned*)(lds + XB_LDS_OFF))[2]); \
            const int T8 = (int)(tw_ & 0xffffu), j8 = (int)((tw_ >> 16) & 7u), NT8 = (int)gridDim.x >> 3, mb = j8 & 3; (void)mb; (void)NT8;
#define TEAM_ROWTILE(pr_) (j8 < 4 ? (pr_) : 63 - (pr_))
#define TEAM_SYNC(k_) do { TEAM_INFO if ((tw_ >> 19) & 1u) { unsigned char* wsb_ = kparams().v.ws; team_barrier((unsigned*)(wsb_ + OFF_TEAM) + T8 * 16, 8u * (unsigned)(layer * 4 + (k_) + 1), (unsigned*)(wsb_ + OFF_BAR)); } else xcd_barrier(xb); } while (0)
            { PH_BEGIN TEAM_INFO phase3(q, layer, lds, wv, T8, j8, NT8); }
            { PH_BEGIN TEAM_INFO __syncthreads(); phase2_attn(q, layer, lds, wv, T8, j8, NT8); }
            TEAM_SYNC(0);
            { PH_BEGIN TEAM_INFO
              pg8::Gemm g{(const bf16_t*)(ws + OFF_OA), (const bf16_t*)(wl + W_BR), 3 * S_LEN, 3 * 1024, 512};
              EpiMix3 E{(const unsigned char*)(ws + OFF_G8), (bf16_t*)(ws + OFF_QALL)};
#pragma unroll 1
              for (int pr = T8; pr < 32; pr += NT8) { TeamBranch S{TEAM_ROWTILE(pr), mb}; pg8::gemm_phase<EpiMix3, TeamBranch, true, true>(lds, g, S, E, wv); } }
            TEAM_SYNC(1);
            { PH_BEGIN TEAM_INFO
              pg8::Gemm g{(const bf16_t*)(ws + OFF_QALL), (const bf16_t*)(wl + W_OUT), S_LEN, 1024, 1024};
              EpiOut<(layer != 0)> E{layer == 0 ? (const void*)q.x : (const void*)(ws + OFF_XS), (bf16_t*)(ws + OFF_H), (float*)(ws + OFF_ROWSS), ws + OFF_H8};
#pragma unroll 1
              for (int pr = T8; pr < 32; pr += NT8) { OneUnit O; O.u.pm = TEAM_ROWTILE(pr); O.u.pn = mb; pg8::gemm_phase<EpiOut<(layer != 0)>, OneUnit, true, true>(lds, g, O, E, wv); } }
            TEAM_SYNC(2);
            { PH_BEGIN TEAM_INFO
              pg8::Gemm g{(const bf16_t*)(ws + OFF_H8), (const bf16_t*)(ws + OFF_WQ8 + (size_t)layer * 2048 * 1024), S_LEN, 2048, 512};
              EpiQrTopk E{(const float*)(ws + OFF_ROWSS), (const bf16_t*)(wl + W_KP), (int*)(ws + OFF_PIDS), (float*)(ws + OFF_PGT)};
#pragma unroll 1
              for (int pr = T8; pr < 32; pr += NT8)
#pragma unroll 1
                  for (int j = 0; j < 2; ++j) { OneUnit O; O.u.pm = TEAM_ROWTILE(pr); O.u.pn = 2 * mb + j; pg8::gemm_phase<EpiQrTopk, OneUnit, true, true, true>(lds, g, O, E, wv); } }
            TEAM_SYNC(3);
            { PH_BEGIN TEAM_INFO
#pragma unroll 1
              for (int pr = T8; pr < 32; pr += NT8) { const int tb_ = 256 * TEAM_ROWTILE(pr) + 64 * mb; phase_peer_gather(q, lds, layer, wv, tb_, 8, tb_ + 64); } }
#undef TEAM_SYNC
#undef TEAM_INFO
#undef TEAM_ROWTILE
        }
        if (layer + 1 < NLAYER) {
            __syncthreads();
            { PH_BEGIN conv_jobs<true>(q, lds, opaque_tid(wv), (layer + 1) * TJ_LAYER, (layer + 2) * TJ_LAYER, (unsigned*)(ws + OFF_BAR) + 64 + 16 * layer); }
            xcd_barrier(xb);
        }
}

__global__ void __launch_bounds__(NTHREADS, 2) mega(Params p_unused) {
    extern __shared__ __attribute__((aligned(16))) unsigned char lds_raw[];
    LAS unsigned char* lds = (LAS unsigned char*)lds_raw;
    const int wv = __builtin_amdgcn_readfirstlane((int)(threadIdx.x >> 6));
    if (threadIdx.x < 4) ((LAS unsigned*)(lds + XB_LDS_OFF))[threadIdx.x] = 0u;
    __syncthreads();
    XcdBarrier xb;
    { const KP kp_ = kparams(); const Params& q = kp_.v; xb = xcd_barrier_post((unsigned*)(q.ws + OFF_BAR), (volatile LAS unsigned*)(lds + XB_LDS_OFF)); }
    if (threadIdx.x == 0) { const KP kp_ = kparams(); ((volatile LAS unsigned*)(lds + XB_LDS_OFF))[3] = xb_add((unsigned*)(kp_.v.ws + OFF_RANK) + 16 * xb.x, 1u); }
    { const KP kp_ = kparams(); phase_prologue(kp_.v, lds, wv); }
    xcd_barrier(xb);
    {
        const KP kp_ = kparams(); unsigned* bar = (unsigned*)(kp_.v.ws + OFF_BAR);
        const unsigned G_ = gridDim.x, bid_ = blockIdx.x;
        unsigned good = (G_ == 256u) ? 1u : 0u;
#pragma unroll
        for (unsigned j = 0; j < 16; ++j) { const unsigned cj = xb_ld(&bar[XB_XCNT(j)]); good &= (cj == (j < 8 ? 32u : 0u)) ? 1u : 0u; }
        const unsigned rank = ((volatile LAS unsigned*)(lds + XB_LDS_OFF))[3];
        const unsigned T = good ? xb.x * 4u + (rank >> 3) : (bid_ >> 3), mbr = good ? (rank & 7u) : (bid_ & 7u);
        __syncthreads();
        if (threadIdx.x == 0) ((volatile LAS unsigned*)(lds + XB_LDS_OFF))[2] = T | (mbr << 16) | (good << 19);
    }
    __syncthreads();
    layer_body<0>(lds, wv, xb);
    layer_body<1>(lds, wv, xb);
}

extern "C" void kernel_launch(void* const* d_in, const int* in_sizes, int n_in, void* d_out, int out_size, void* d_ws, size_t ws_size,
                              hipStream_t stream) {
    static int grid_blocks = 0;
    if (grid_blocks == 0) {
        int dev = 0, cus = 0, per_cu = 0;
        if (hipGetDevice(&dev) != hipSuccess || hipDeviceGetAttribute(&cus, hipDeviceAttributeMultiprocessorCount, dev) != hipSuccess) { fprintf(stderr, "device query failed\n"); grid_blocks = -1; return; }
        if (hipFuncSetAttribute((const void*)mega, hipFuncAttributeMaxDynamicSharedMemorySize, LDS_BYTES) != hipSuccess) { fprintf(stderr, "hipFuncSetAttribute failed\n"); grid_blocks = -1; return; }
        if (hipOccupancyMaxActiveBlocksPerMultiprocessor(&per_cu, (const void*)mega, NTHREADS, LDS_BYTES) != hipSuccess || per_cu < 1) { fprintf(stderr, "occupancy query failed (%d)\n", per_cu); grid_blocks = -1; return; }
        if (ws_size < WS_END) { fprintf(stderr, "workspace too small: %zu < %zu\n", ws_size, (size_t)WS_END); grid_blocks = -1; return; }
        grid_blocks = cus & ~7;
        if (grid_blocks < 8 || grid_blocks > 512) { fprintf(stderr, "unsupported CU count %d\n", cus); grid_blocks = -1; return; }
    }
    if (grid_blocks < 0) return;
    if (hipMemsetAsync((char*)d_ws + OFF_BAR, 0, 32768, stream) != hipSuccess) { fprintf(stderr, "memset failed\n"); return; }
    Params p{};
    p.x = (const float*)d_in[0]; p.norm1 = (const float*)d_in[1]; p.w_in = (const float*)d_in[2]; p.sinks = (const float*)d_in[3];
    p.cmp_pos = (const float*)d_in[4]; p.cmp_w1 = (const float*)d_in[5]; p.cmp_w2 = (const float*)d_in[6]; p.w_branch = (const float*)d_in[7];
    p.w_out = (const float*)d_in[8]; p.norm2 = (const float*)d_in[9]; p.peer_wq = (const float*)d_in[10]; p.peer_keys = (const float*)d_in[11];
    p.peer_u = (const float*)d_in[12]; p.peer_v = (const float*)d_in[13]; p.norm_f = (const float*)d_in[14];
    p.out = (float*)d_out; p.ws = (unsigned char*)d_ws;
    void* args[] = {&p};
    hipError_t e = hipLaunchCooperativeKernel((const void*)mega, dim3(grid_blocks), dim3(NTHREADS), args, LDS_BYTES, stream);
    if (e != hipSuccess) fprintf(stderr, "cooperative launch failed: %s (grid %d)\n", hipGetErrorString(e), grid_blocks);
}
```

```cpp
#include <hip/hip_runtime.h>
#include <hip/hip_cooperative_groups.h>
#include <cstdio>
#include <cstdint>
namespace cg = cooperative_groups;

#define LAS __attribute__((address_space(3)))
typedef unsigned short bf16_t;
typedef short bf16x8 __attribute__((ext_vector_type(8)));
typedef float f32x4 __attribute__((ext_vector_type(4)));
typedef float f32x16 __attribute__((ext_vector_type(16)));
typedef unsigned u32x4 __attribute__((ext_vector_type(4)));
typedef unsigned u32x2 __attribute__((ext_vector_type(2)));

constexpr int S_LEN = 16384, DM = 1024, NLAYER = 2;
constexpr int NTHREADS = 512;
constexpr int LDS_BYTES = 144 * 1024;
constexpr int NMAIN = 5888, NVT = 1024, RW = 512, RFOOT = 3456;
constexpr int R_KCB = 0, R_VCB = 128, R_GB = 256;
constexpr int D_IN = 6680;
constexpr size_t PLANE = (size_t)S_LEN * 64;
constexpr float RMS_EPS = 1e-6f;
constexpr float LOG2E = 1.4426950408889634f;
constexpr float NEGV = -1e30f;
constexpr float U4_SCALE = 64.0f, V4_SCALE = 5.5f;

constexpr size_t OFF_BAR = 0;
constexpr size_t OFF_TICKET = OFF_BAR + 16384;
constexpr size_t OFF_ROWSS = 768 * 1024;
constexpr size_t OFF_CBIAS = 128 * 1024;
constexpr size_t OFF_KCMP = 256 * 1024;
constexpr size_t OFF_VCMP = 512 * 1024;
constexpr size_t OFF_W = 2048 * 1024;
constexpr size_t W_IN = 0;
constexpr size_t W_VT = W_IN + (size_t)NMAIN * 1024 * 2;
constexpr size_t W_BR = W_VT + (size_t)NVT * 1024 * 2;
constexpr size_t W_OUT = W_BR + (size_t)3 * 1024 * 512 * 2;
constexpr size_t W_Q = W_OUT + (size_t)1024 * 1024 * 2;
constexpr size_t W_KP = W_Q + (size_t)2048 * 1024 * 2;
constexpr size_t W_1T = W_KP + (size_t)2 * 8 * 128 * 128 * 2;
constexpr size_t W_2T = W_1T + (size_t)2 * 128 * 2048 * 2;
constexpr size_t LW = W_2T + (size_t)2 * 64 * 128 * 2;
constexpr size_t OFF_U = OFF_W + 2 * LW;
constexpr size_t OFF_V = OFF_U + (size_t)16384 * 1024 * 2;
constexpr size_t OFF_XS = OFF_V + (size_t)16384 * 1024 * 2;
constexpr size_t OFF_H = OFF_XS + (size_t)S_LEN * DM * 4;
constexpr size_t OFF_QALL = OFF_H + (size_t)S_LEN * DM * 2;
constexpr size_t OFF_KALL = OFF_QALL + 24 * PLANE * 2;
constexpr size_t OFF_VALL = OFF_KALL + 14 * PLANE * 2;
constexpr size_t OFF_R = OFF_VALL + 14 * PLANE * 2;
constexpr size_t OFF_G8 = OFF_R + (size_t)S_LEN * RW * 2;
constexpr size_t OFF_PIDS = OFF_G8 + (size_t)64 * 12 * 8 * 8 * 1024;
constexpr size_t OFF_PGT = OFF_PIDS + (size_t)S_LEN * 128 * 4;
static_assert(OFF_PGT + (size_t)S_LEN * 128 * 4 <= OFF_R + (size_t)S_LEN * RFOOT * 2, "gate / id buffers exceed the region");
constexpr size_t OFF_TEAM = OFF_BAR + 20480;
constexpr size_t OFF_RANK = OFF_BAR + 30720;
constexpr size_t OFF_OA = OFF_R + (size_t)S_LEN * RFOOT * 2;
constexpr size_t OFF_OB = OFF_OA + (size_t)S_LEN * 512 * 2;
constexpr size_t OFF_OC = OFF_OB + (size_t)S_LEN * 512 * 2;
constexpr size_t OFF_WG8 = OFF_OC + (size_t)S_LEN * 512 * 2;
constexpr size_t OFF_H8 = OFF_WG8 + (size_t)NLAYER * 3072 * 1024;
constexpr size_t OFF_WQ8 = OFF_H8 + (size_t)S_LEN * DM;
constexpr size_t WS_END = OFF_WQ8 + (size_t)NLAYER * 2048 * 1024;
constexpr float WG_SCALE = 32.0f;
constexpr float X8_SCALE = 8.0f;
static_assert(WS_END < 520u * 1024 * 1024, "workspace too large");
static_assert((LW % 256) == 0, "align");

constexpr int XB_LDS_OFF = 143360;
struct Params {
    const float* x; const float* norm1; const float* w_in; const float* sinks; const float* cmp_pos; const float* cmp_w1;
    const float* cmp_w2; const float* w_branch; const float* w_out; const float* norm2; const float* peer_wq;
    const float* peer_keys; const float* peer_u; const float* peer_v; const float* norm_f;
    float* out; unsigned char* ws;
};

__device__ __forceinline__ int opaque_bid() { int b = blockIdx.x; asm volatile("" : "+s"(b)); return b; }
__device__ __forceinline__ int opaque_tid(int wv) { unsigned z = 0u; asm volatile("" : "+s"(z));
    int t = wv * 64 + (int)__builtin_amdgcn_mbcnt_hi(~0u, __builtin_amdgcn_mbcnt_lo(~0u, z)); asm volatile("" : "+v"(t)); return t; }
typedef float f32x2_t __attribute__((ext_vector_type(2)));
typedef __bf16 bf16x2_t __attribute__((ext_vector_type(2)));
__device__ __forceinline__ unsigned cvt_pk_bf16(float lo, float hi) { const f32x2_t v = {lo, hi}; return __builtin_bit_cast(unsigned, __builtin_convertvector(v, bf16x2_t)); }
__device__ __forceinline__ float bf_lo(unsigned w) { return __uint_as_float(w << 16); }
__device__ __forceinline__ float bf_hi(unsigned w) { return __uint_as_float(w & 0xffff0000u); }
__device__ __forceinline__ float fast_exp2(float x) { return __builtin_amdgcn_exp2f(x); }
__device__ __forceinline__ float fast_exp(float x) { return __builtin_amdgcn_exp2f(x * LOG2E); }
__device__ __forceinline__ float fast_rcp(float x) { return __builtin_amdgcn_rcpf(x); }
__device__ __forceinline__ float sigmoidf_(float x) { return fast_rcp(1.0f + fast_exp(-x)); }
__device__ __forceinline__ float gelu_tanh(float x) {
    const float u = 0.7978845608028654f * (x + 0.044715f * x * x * x);
    return x * fast_rcp(1.0f + fast_exp(-2.0f * u));
}
template <int CTRL> __device__ __forceinline__ float dpp_f(float v) { return __int_as_float(__builtin_amdgcn_update_dpp(0, __float_as_int(v), CTRL, 0xf, 0xf, true)); }
template <int CTRL> __device__ __forceinline__ unsigned dpp_u(unsigned v) { return (unsigned)__builtin_amdgcn_update_dpp(0, (int)v, CTRL, 0xf, 0xf, true); }
__device__ __forceinline__ float wave_sum(float v) {
    v += dpp_f<0xB1>(v); v += dpp_f<0x4E>(v); v += dpp_f<0x141>(v); v += dpp_f<0x140>(v);
    const float a = __int_as_float(__builtin_amdgcn_readlane(__float_as_int(v), 0)), b = __int_as_float(__builtin_amdgcn_readlane(__float_as_int(v), 16));
    const float c = __int_as_float(__builtin_amdgcn_readlane(__float_as_int(v), 32)), d = __int_as_float(__builtin_amdgcn_readlane(__float_as_int(v), 48));
    return (a + b) + (c + d);
}
__device__ __forceinline__ float xor32(float v) { return __shfl_xor(v, 32); }
#define MFMA32(a, b, c) __builtin_amdgcn_mfma_f32_32x32x16_bf16((a), (b), (c), 0, 0, 0)
#define ROWOFF(r) (((r) & 3) + 8 * ((r) >> 2))
__device__ __forceinline__ bf16x8 pack8(float a0, float a1, float a2, float a3, float a4, float a5, float a6, float a7) {
    u32x4 w; w.x = cvt_pk_bf16(a0, a1); w.y = cvt_pk_bf16(a2, a3); w.z = cvt_pk_bf16(a4, a5); w.w = cvt_pk_bf16(a6, a7);
    return __builtin_bit_cast(bf16x8, w);
}
__device__ __forceinline__ f32x16 zero16() { f32x16 z;
#pragma unroll
    for (int i = 0; i < 16; ++i) z[i] = 0.f;
    return z; }
__device__ __forceinline__ unsigned f2ord(float f) { const unsigned b = __float_as_uint(f); return b ^ ((b & 0x80000000u) ? 0xffffffffu : 0x80000000u); }
__device__ __forceinline__ float ord2f(unsigned u) { const unsigned b = u ^ ((u & 0x80000000u) ? 0x80000000u : 0xffffffffu); return __uint_as_float(b); }
__device__ __forceinline__ unsigned med3u(unsigned a, unsigned b, unsigned c) { const unsigned mn = a < b ? a : b, mx = a < b ? b : a; const unsigned t = mx < c ? mx : c; return mn > t ? mn : t; }
__device__ __forceinline__ void top16_insert(unsigned (&l)[16], unsigned k) {
    unsigned n[16];
    n[0] = l[0] > k ? l[0] : k;
#pragma unroll
    for (int i = 1; i < 16; ++i) n[i] = med3u(l[i - 1], l[i], k);
#pragma unroll
    for (int i = 0; i < 16; ++i) l[i] = n[i];
    __builtin_amdgcn_sched_barrier(0);
}
#define XB_TMO      128
#define XB_XCNT(j)  (256  + 64 * (j))
#define XB_XSUB(j)  (1280 + 64 * (j))
#define XB_XGEN(j)  (2304 + 64 * (j))
#define XB_TOP      3328
#define XB_TOPGEN   3392
#define XCD_BAR_WORDS 3456
#define XB_SPIN_CAP (1u << 18)

__device__ __forceinline__ unsigned xb_ld(unsigned* p)              { return __hip_atomic_load(p, __ATOMIC_RELAXED, __HIP_MEMORY_SCOPE_AGENT); }
__device__ __forceinline__ unsigned xb_add(unsigned* p, unsigned v) { return __hip_atomic_fetch_add(p, v, __ATOMIC_RELAXED, __HIP_MEMORY_SCOPE_AGENT); }
__device__ __forceinline__ unsigned xb_xcc_id() { return (unsigned)__builtin_amdgcn_s_getreg((3 << 11) | 20) & 0xFu; }
#define XB_SPIN(cond, bar) do { unsigned _sp = 0; while (cond) { __builtin_amdgcn_s_sleep(1); \
    if ((++_sp & 255u) == 0u) { if (xb_ld(&(bar)[XB_TMO])) break; if (_sp > XB_SPIN_CAP) { atomicAdd(&(bar)[XB_TMO], 1u); break; } } } } while (0)

struct XcdBarrier {
    unsigned* bar; unsigned x;
    volatile LAS unsigned* st;
};

__device__ __forceinline__ XcdBarrier xcd_barrier_post(unsigned* bar, volatile LAS unsigned* st) {
    XcdBarrier b; b.bar = bar; b.x = xb_xcc_id(); b.st = st;
    if (threadIdx.x == 0) (void)xb_add(&bar[XB_XCNT(b.x)], 1u);
    return b;
}
__device__ __forceinline__ void xcd_barrier_complete(unsigned* bar, unsigned x, unsigned& nloc, unsigned& nx) {
    const unsigned G = gridDim.x * gridDim.y * gridDim.z;
    unsigned sum, cnt, mine, sp = 0u;
    for (;;) {
        sum = 0u; cnt = 0u; mine = 0u;
#pragma unroll
        for (unsigned j = 0; j < 16; ++j) { const unsigned c = xb_ld(&bar[XB_XCNT(j)]); sum += c; cnt += (c > 0u) ? 1u : 0u; mine = (j == x) ? c : mine; }
        if (sum == G) break;
        __builtin_amdgcn_s_sleep(1);
        if ((++sp & 255u) == 0u) { if (xb_ld(&bar[XB_TMO])) break; if (sp > XB_SPIN_CAP) { atomicAdd(&bar[XB_TMO], 1u); break; } }
    }
    nloc = mine > 0u ? mine : 1u; nx = cnt > 0u ? cnt : 1u;
}

__device__ __forceinline__ void xcd_barrier(const XcdBarrier& b) {
    asm volatile("s_waitcnt vmcnt(0)" ::: "memory");
    __syncthreads();
    if (threadIdx.x == 0) {
        unsigned* bar = b.bar;
        __builtin_amdgcn_s_waitcnt(0);
        unsigned nloc = b.st[0], nx = b.st[1];
        if (nloc == 0u) { xcd_barrier_complete(bar, b.x, nloc, nx); b.st[0] = nloc; b.st[1] = nx; }
        const unsigned old = xb_add(&bar[XB_XSUB(b.x)], 1u);
        const unsigned gen = old / nloc;
        if (old + 1u == (gen + 1u) * nloc) {
            __builtin_amdgcn_fence(__ATOMIC_RELEASE, "agent");
            asm volatile("s_waitcnt vmcnt(0)" ::: "memory");
            const unsigned og = xb_add(&bar[XB_TOP], 1u);
            const unsigned tg = og / nx;
            if (og + 1u == (tg + 1u) * nx) xb_add(&bar[XB_TOPGEN], 1u);
            else XB_SPIN(xb_ld(&bar[XB_TOPGEN]) == tg, bar);
            __builtin_amdgcn_fence(__ATOMIC_ACQUIRE, "agent");
            xb_add(&bar[XB_XGEN(b.x)], 1u);
            asm volatile("s_waitcnt vmcnt(0)" ::: "memory");
        } else {
            XB_SPIN(xb_ld(&bar[XB_XGEN(b.x)]) == gen, bar);
            __builtin_amdgcn_fence(__ATOMIC_ACQUIRE, "agent");
            asm volatile("s_waitcnt vmcnt(0)" ::: "memory");
        }
    }
    __syncthreads();
}
namespace pg8 {
#define PG8_LAS __attribute__((address_space(3)))
typedef unsigned short bf16_t;
typedef short bf16x8 __attribute__((ext_vector_type(8)));
typedef float f32x4 __attribute__((ext_vector_type(4)));
typedef unsigned u32x4 __attribute__((ext_vector_type(4)));
constexpr int BM = 256, BK = 64, HALF = 128, HTB = HALF * BK * 2  , STAGE_BYTES = 8 * HTB, NXCD = 8, WGM = 8;

__host__ __device__ __forceinline__ int lds_byte(int r, int c) { const int st = (r >> 4) * 2 + (c >> 5), rr = r & 15, cc = c & 31, ob = rr * 64 + cc * 2; return st * 1024 + (ob ^ (((ob >> 9) & 1) << 5)); }
__host__ __device__ __forceinline__ void stage_rc(int b, int& R, int& C) { const int st = b / 1024, sb = b % 1024, swz = sb ^ (((sb >> 9) & 1) << 5); R = (st >> 1) * 16 + swz / 64; C = (st & 1) * 32 + (swz % 64) / 2; }
__host__ __device__ __forceinline__ int perm32(int rho) { const int n = rho >> 4, i = rho & 15; return 8 * (i >> 2) + 4 * n + (i & 3); }

typedef int pg8_i32x4 __attribute__((ext_vector_type(4)));
struct Unit { int pm, pn; };
struct Gemm { const bf16_t* A; const bf16_t* Bt; int M, N, K; };

struct StaticOrder {
    int nM, nN, nwg, G, c, lim;
    __host__ __device__ void init(int M, int N, int G_, int c_) { nM = M / BM; nN = N / BM; nwg = nM * nN; G = G_; c = c_; lim = nwg; }
    __host__ __device__ bool next(int i, Unit& u) const {
        const long L = (long)i * G + c; if (L >= lim) return false;
        int wgid = (int)L; { const int q = nwg / NXCD, r = nwg % NXCD, xcd = wgid % NXCD, off = wgid / NXCD; wgid = (xcd < r ? xcd * (q + 1) : r * (q + 1) + (xcd - r) * q) + off; }
        const int nig = WGM * nN, gid = wgid / nig, fm = gid * WGM, gsz = (nM - fm) < WGM ? (nM - fm) : WGM;
        u.pm = fm + ((wgid % nig) % gsz); u.pn = (wgid % nig) / gsz; return true;
    }
    __device__ __forceinline__ void a_ready(const Unit&) const {}
    __device__ __forceinline__ void done(const Unit&) const {}
};
template <class Epi, class Sched, bool ALIGN_EPI = false, bool SP2 = false, bool FP8 = false>
__device__ __forceinline__ void gemm_phase(PG8_LAS unsigned char* lds, const Gemm g, const Sched& S, const Epi& E, int wv) {
    unsigned z_ = 0u; asm volatile("" : "+s"(z_)); int tid_ = wv * 64 + (int)__builtin_amdgcn_mbcnt_hi(~0u, __builtin_amdgcn_mbcnt_lo(~0u, z_)); asm volatile("" : "+v"(tid_));
    const int tid = tid_, wid = __builtin_amdgcn_readfirstlane(tid >> 6), lane = tid & 63, wr = wid >> 2, wc = wid & 3, fr = lane & 15, fq = lane >> 4;
    const int K = g.K, nt = K / BK;
    unsigned voffA[2], voffB[2];
#pragma unroll
    for (int i = 0; i < 2; ++i) { int R, C; stage_rc(tid * 16 + i * 8192, R, C); const int Rb = Epi::PERM ? ((R & ~31) + perm32(R & 31)) : R;
        voffA[i] = (unsigned)(R * K + C) * 2u; voffB[i] = (unsigned)(Rb * K + C) * 2u; }
    const size_t kstep = (size_t)(BK * 2);
    const size_t hstep = (size_t)HALF * K * 2;
    const size_t tstep = 2 * hstep;
    const unsigned ldsw = (unsigned)wid * 1024u;
    const int aoff = lds_byte(wr * 64 + fr, fq * 8), boff = lds_byte(wc * 32 + fr, fq * 8);
#define PG8_SA(b, h) (((b) * 2 + (h)) * HTB)
#define PG8_SB(b, h) ((4 + (b) * 2 + (h)) * HTB)
#define PG8_STAGE(bufoff, gbase, voff) do { _Pragma("unroll") for (int _i = 0; _i < 2; ++_i) \
        __builtin_amdgcn_global_load_lds((const unsigned*)((const char*)(gbase) + (voff)[_i]), (PG8_LAS unsigned*)(lds + (bufoff) + ldsw + _i * 8192), 16, 0, 0); } while (0)
#define PG8_LDA(dst, b, h) do { _Pragma("unroll") for (int m = 0; m < 4; ++m) _Pragma("unroll") for (int k = 0; k < 2; ++k) dst[m][k] = *(const PG8_LAS bf16x8*)(lds + PG8_SA(b, h) + aoff + m * 2048 + k * 1024); } while (0)
#define PG8_LDB(dst, b, h) do { _Pragma("unroll") for (int n = 0; n < 2; ++n) _Pragma("unroll") for (int k = 0; k < 2; ++k) dst[n][k] = *(const PG8_LAS bf16x8*)(lds + PG8_SB(b, h) + boff + n * 2048 + k * 1024); } while (0)
#define PG8_CAT8(x_, y_) __builtin_shufflevector(__builtin_bit_cast(pg8_i32x4, (x_)), __builtin_bit_cast(pg8_i32x4, (y_)), 0, 1, 2, 3, 4, 5, 6, 7)
#define PG8_MMA(ai, bj, At, Bt) do { __builtin_amdgcn_s_setprio(1); _Pragma("unroll") for (int m = 0; m < 4; ++m) _Pragma("unroll") for (int n = 0; n < 2; ++n) { \
        if constexpr (FP8) { asm volatile("v_mfma_scale_f32_16x16x128_f8f6f4 %0, %1, %2, %0, %3, %3 op_sel_hi:[0,0,0]" : "+v"(acc[ai][bj][m][n]) : "v"(PG8_CAT8(Bt[n][0], Bt[n][1])), "v"(PG8_CAT8(At[m][0], At[m][1])), "v"(sc1)); } \
        else { _Pragma("unroll") for (int k = 0; k < 2; ++k) acc[ai][bj][m][n] = __builtin_amdgcn_mfma_f32_16x16x32_bf16(Bt[n][k], At[m][k], acc[ai][bj][m][n], 0, 0, 0); } } \
        __builtin_amdgcn_s_setprio(0); } while (0)
#define PG8_WAIT_V(n) asm volatile("s_waitcnt vmcnt(" #n ")" ::: "memory")
#define PG8_WAIT_L(n) asm volatile("s_waitcnt lgkmcnt(" #n ")" ::: "memory")
#define PG8_BAR __builtin_amdgcn_s_barrier()
#define PG8_SCHED __builtin_amdgcn_sched_barrier(0)
    Unit cur, nxt; int ui = 0;
    [[maybe_unused]] int sc1 = 0x7F7F7F7F; if constexpr (FP8) asm volatile("" : "+v"(sc1));
    if (!S.next(0, cur)) return;
    f32x4 acc[2][2][4][2];
#pragma unroll
    for (int a = 0; a < 2; ++a)
#pragma unroll
        for (int b = 0; b < 2; ++b)
#pragma unroll
            for (int m = 0; m < 4; ++m)
#pragma unroll
                for (int n = 0; n < 2; ++n) acc[a][b][m][n] = (f32x4){0.f, 0.f, 0.f, 0.f};
    bf16x8 At[4][2], B0[2][2], B1[2][2];
    const char* cA = (const char*)g.A + (size_t)cur.pm * tstep; const char* cB = (const char*)g.Bt + (size_t)cur.pn * tstep;
    S.a_ready(cur);
    if constexpr (SP2) {
        PG8_STAGE(PG8_SB(0, 0), cB, voffB); PG8_STAGE(PG8_SB(0, 1), cB + hstep, voffB); PG8_STAGE(PG8_SA(0, 0), cA, voffA); PG8_STAGE(PG8_SA(0, 1), cA + hstep, voffA);
        if (wr == 1) PG8_BAR;
        PG8_WAIT_V(2); PG8_BAR;
        PG8_STAGE(PG8_SB(1, 0), cB + kstep, voffB); PG8_STAGE(PG8_SA(1, 0), cA + kstep, voffA); PG8_STAGE(PG8_SB(1, 1), cB + hstep + kstep, voffB);
        PG8_WAIT_V(6); PG8_BAR;
    } else {
        PG8_STAGE(PG8_SB(0, 0), cB, voffB); PG8_STAGE(PG8_SA(0, 0), cA, voffA); PG8_STAGE(PG8_SB(0, 1), cB + hstep, voffB); PG8_STAGE(PG8_SA(0, 1), cA + hstep, voffA);
        if (wr == 1) PG8_BAR;
        PG8_WAIT_V(4); PG8_BAR;
        PG8_STAGE(PG8_SB(1, 0), cB + kstep, voffB); PG8_STAGE(PG8_SA(1, 0), cA + kstep, voffA); PG8_STAGE(PG8_SB(1, 1), cB + hstep + kstep, voffB);
        PG8_WAIT_V(6); PG8_BAR;
    }
    for (;;) {
        const bool has_next = S.next(ui + 1, nxt);
        const char* nA = has_next ? (const char*)g.A + (size_t)nxt.pm * tstep : cA; const char* nB = has_next ? (const char*)g.Bt + (size_t)nxt.pn * tstep : cB;
        for (int t = 0; t < nt; t += 2) {
            const bool last = (t == nt - 2);
            const char* a1 = cA + (size_t)(t + 1) * kstep;
            const char* a2 = last ? nA : cA + (size_t)(t + 2) * kstep; const char* b2 = last ? nB : cB + (size_t)(t + 2) * kstep;
            const char* a3 = a2 + kstep; const char* b3 = b2 + kstep;
            if (last && has_next) S.a_ready(nxt);
            if constexpr (SP2) {
            PG8_LDB(B0, 0, 0); PG8_LDB(B1, 0, 1); PG8_SCHED; PG8_LDA(At, 0, 0); PG8_STAGE(PG8_SA(1, 1), a1 + hstep, voffA);
            PG8_WAIT_V(8); PG8_WAIT_L(0); PG8_BAR; PG8_MMA(0, 0, At, B0); PG8_MMA(0, 1, At, B1); PG8_BAR; PG8_SCHED;
            PG8_LDA(At, 0, 1); PG8_STAGE(PG8_SB(0, 0), b2, voffB); PG8_STAGE(PG8_SB(0, 1), b2 + hstep, voffB); PG8_STAGE(PG8_SA(0, 0), a2, voffA);
            PG8_WAIT_V(8); PG8_WAIT_L(0); PG8_BAR; PG8_MMA(1, 0, At, B0); PG8_MMA(1, 1, At, B1); PG8_BAR; PG8_SCHED;
            PG8_LDB(B0, 1, 0); PG8_LDB(B1, 1, 1); PG8_SCHED; PG8_LDA(At, 1, 0); PG8_STAGE(PG8_SA(0, 1), a2 + hstep, voffA);
            PG8_WAIT_V(8); PG8_WAIT_L(0); PG8_BAR; PG8_MMA(0, 0, At, B0); PG8_MMA(0, 1, At, B1); PG8_BAR; PG8_SCHED;
            PG8_LDA(At, 1, 1); PG8_STAGE(PG8_SB(1, 0), b3, voffB); PG8_STAGE(PG8_SB(1, 1), b3 + hstep, voffB); PG8_STAGE(PG8_SA(1, 0), a3, voffA);
            PG8_WAIT_V(8); PG8_WAIT_L(0); PG8_BAR; PG8_MMA(1, 0, At, B0); PG8_MMA(1, 1, At, B1); PG8_BAR; PG8_SCHED;
            } else {
            PG8_LDB(B0, 0, 0); PG8_SCHED; PG8_LDA(At, 0, 0); PG8_STAGE(PG8_SA(1, 1), a1 + hstep, voffA);
            PG8_WAIT_L(8); PG8_BAR; PG8_WAIT_L(0); PG8_MMA(0, 0, At, B0); PG8_BAR; PG8_SCHED;
            PG8_LDB(B1, 0, 1); PG8_STAGE(PG8_SB(0, 0), b2, voffB);
            PG8_BAR; PG8_WAIT_L(0); PG8_MMA(0, 1, At, B1); PG8_BAR;
            PG8_LDA(At, 0, 1); PG8_STAGE(PG8_SA(0, 0), a2, voffA);
            PG8_BAR; PG8_WAIT_L(0); PG8_MMA(1, 0, At, B0); PG8_BAR; PG8_SCHED;
            PG8_STAGE(PG8_SB(0, 1), b2 + hstep, voffB);
            PG8_WAIT_V(6); PG8_BAR; PG8_MMA(1, 1, At, B1); PG8_BAR;
            PG8_LDB(B0, 1, 0); PG8_SCHED; PG8_LDA(At, 1, 0); PG8_STAGE(PG8_SA(0, 1), a2 + hstep, voffA);
            PG8_WAIT_L(8); PG8_BAR; PG8_WAIT_L(0); PG8_MMA(0, 0, At, B0); PG8_BAR; PG8_SCHED;
            PG8_LDB(B1, 1, 1); PG8_STAGE(PG8_SB(1, 0), b3, voffB);
            PG8_BAR; PG8_WAIT_L(0); PG8_MMA(0, 1, At, B1); PG8_BAR;
            PG8_LDA(At, 1, 1); PG8_STAGE(PG8_SA(1, 0), a3, voffA);
            PG8_BAR; PG8_WAIT_L(0); PG8_MMA(1, 0, At, B0); PG8_BAR; PG8_SCHED;
            PG8_STAGE(PG8_SB(1, 1), b3 + hstep, voffB);
            PG8_WAIT_V(6); PG8_BAR; PG8_MMA(1, 1, At, B1); PG8_BAR;
            }
        }
        if constexpr (ALIGN_EPI) { if (wr == 0) PG8_BAR; }
        if constexpr (!Epi::AFTER_DRAIN) { E(acc, cur, wr, wc, fr, fq); S.done(cur); }
        if (!has_next) break;
#pragma unroll
        for (int a = 0; a < 2; ++a)
#pragma unroll
            for (int b = 0; b < 2; ++b)
#pragma unroll
                for (int m = 0; m < 4; ++m)
#pragma unroll
                    for (int n = 0; n < 2; ++n) acc[a][b][m][n] = (f32x4){0.f, 0.f, 0.f, 0.f};
        cur = nxt; cA = nA; cB = nB; ++ui;
        if constexpr (ALIGN_EPI) { if (wr == 1) PG8_BAR; }
    }
    PG8_WAIT_V(0);
    if constexpr (!ALIGN_EPI) { if (wr == 0) PG8_BAR; }
    PG8_BAR;
    if constexpr (Epi::AFTER_DRAIN) { E.fused(acc, cur, wr, wc, fr, fq, lds, wid, lane); S.done(cur); }
#undef PG8_SA
#undef PG8_SB
#undef PG8_STAGE
#undef PG8_LDA
#undef PG8_LDB
#undef PG8_MMA
#undef PG8_WAIT_V
#undef PG8_WAIT_L
#undef PG8_BAR
#undef PG8_SCHED
}
}

struct TJob { const float* src; const float* kscale; bf16_t* dst; int ld, col0, nvalid, K, n0, k0, f8; float scale; };

__device__ __forceinline__ int main_srccol(int n, float& scale, int& nvalid) {
    scale = 1.0f; nvalid = 64;
    if (n < 512) { scale = 0.125f * LOG2E; return n; }
    if (n < 1024) { scale = 0.125f * LOG2E; return 768 + (n - 512); }
    if (n < 1536) { scale = 0.125f * LOG2E; return 2072 + (n - 1024); }
    if (n < 1664) return 512 + (n - 1536);
    if (n < 1792) return 1536 + (n - 1664);
    if (n < 1920) return 1792 + (n - 1792);
    if (n < 2432) return 2584 + (n - 1920);
    if (n < 2560) return 1280 + (n - 2432);
    if (n < 2688) return 1408 + (n - 2560);
    if (n < 2752) { nvalid = 24; return 2048; }
    if (n < 2816) { nvalid = 0; return 0; }
    return 3608 + (n - 2816);
}
__device__ __forceinline__ int vt_srccol(int n, int& nvalid) {
    nvalid = 64;
    if (n < 128) return 640 + n;
    if (n < 256) return 1664 + (n - 128);
    if (n < 384) return 1920 + (n - 256);
    if (n < 896) return 3096 + (n - 384);
    nvalid = 0; return 0;
}

constexpr int TJ_IN = 92 * 8, TJ_VT = 16 * 8, TJ_BR = 16 * 4, TJ_OUT = 16 * 8, TJ_Q = 32 * 8, TJ_W1 = 2 * 16, TJ_W2 = 1;
constexpr int TJ_LAYER = TJ_IN + TJ_VT + 3 * TJ_BR + TJ_OUT + TJ_Q + 2 * TJ_W1 + 2 * TJ_W2;

__device__ __forceinline__ TJob decode_job(const Params& p, int job) {
    const int layer = job / TJ_LAYER; int j = job % TJ_LAYER;
    unsigned char* wl = p.ws + OFF_W + (size_t)layer * LW;
    TJob t; t.kscale = nullptr; t.scale = 1.0f; t.nvalid = 64; t.f8 = 0;
    if (j < TJ_IN) { const int nt = j / 8, kt = j % 8; t.col0 = main_srccol(nt * 64, t.scale, t.nvalid);
        t.src = p.w_in + (size_t)layer * DM * D_IN; t.ld = D_IN; t.dst = (bf16_t*)(wl + W_IN); t.K = 1024; t.n0 = nt * 64; t.k0 = kt * 128;
        if (nt >= 44) { t.f8 = 1; t.scale = WG_SCALE; t.n0 = nt * 64 - 2816; t.dst = (bf16_t*)(p.ws + OFF_WG8 + (size_t)layer * 3072 * 1024); }
        return t; }
    j -= TJ_IN;
    if (j < TJ_VT) { const int nt = j / 8, kt = j % 8; t.col0 = vt_srccol(nt * 64, t.nvalid);
        t.src = p.w_in + (size_t)layer * DM * D_IN; t.ld = D_IN; t.dst = (bf16_t*)(wl + W_VT); t.K = 1024; t.n0 = nt * 64; t.k0 = kt * 128; return t; }
    j -= TJ_VT;
    if (j < 3 * TJ_BR) { const int i = j / TJ_BR, jj = j % TJ_BR, nt = jj / 4, kt = jj % 4;
        t.src = p.w_branch + ((size_t)layer * 3 + i) * 512 * 1024; t.ld = 1024; t.col0 = nt * 64; t.dst = (bf16_t*)(wl + W_BR) + (size_t)i * 1024 * 512; t.K = 512; t.n0 = nt * 64; t.k0 = kt * 128; return t; }
    j -= 3 * TJ_BR;
    if (j < TJ_OUT) { const int nt = j / 8, kt = j % 8;
        t.src = p.w_out + (size_t)layer * 1024 * 1024; t.ld = 1024; t.col0 = nt * 64; t.dst = (bf16_t*)(wl + W_OUT); t.K = 1024; t.n0 = nt * 64; t.k0 = kt * 128; return t; }
    j -= TJ_OUT;
    if (j < TJ_Q) { const int nt = j / 8, kt = j % 8;
        t.src = p.peer_wq + (size_t)layer * 1024 * 2048; t.ld = 2048; t.col0 = nt * 64; t.dst = (bf16_t*)(p.ws + OFF_WQ8 + (size_t)layer * 2048 * 1024); t.f8 = 1; t.scale = WG_SCALE; t.K = 1024; t.n0 = nt * 64; t.k0 = kt * 128; t.kscale = p.norm2 + layer * DM; return t; }
    j -= TJ_Q;
    if (j < 2 * TJ_W1) { const int i = j / TJ_W1, jj = j % TJ_W1, nt = jj / 16, kt = jj % 16;
        t.src = p.cmp_w1 + ((size_t)layer * 2 + i) * 2048 * 128; t.ld = 128; t.col0 = nt * 64; t.dst = (bf16_t*)(wl + W_1T) + (size_t)i * 128 * 2048; t.K = 2048; t.n0 = nt * 64; t.k0 = kt * 128; return t; }
    j -= 2 * TJ_W1;
    { const int i = j;
        t.src = p.cmp_w2 + ((size_t)layer * 2 + i) * 128 * 64; t.ld = 64; t.col0 = 0; t.dst = (bf16_t*)(wl + W_2T) + (size_t)i * 64 * 128; t.K = 128; t.n0 = 0; t.k0 = 0; return t; }
}
__device__ __forceinline__ void tjob_load(const TJob& t, int tid, f32x4 (&v)[4], float (&sc)[4]) {
    const int c4 = (tid & 15) * 4;
#pragma unroll
    for (int ps = 0; ps < 4; ++ps) { const int kk = (tid >> 4) + 32 * ps;
        v[ps] = (f32x4){0.f, 0.f, 0.f, 0.f};
        if (c4 < t.nvalid) v[ps] = *(const f32x4*)(t.src + (size_t)(t.k0 + kk) * t.ld + t.col0 + c4);
        sc[ps] = t.scale * (t.kscale ? t.kscale[t.k0 + kk] : 1.0f); }
}
template <bool TICKET>
__device__ __forceinline__ void conv_jobs(const Params& p, LAS unsigned char* lds, int tid, const int jbegin, const int jend, unsigned* ctr) {
    constexpr int TP = 136;
    volatile LAS int* slot = (volatile LAS int*)(lds + 2 * 64 * TP * 2);
    int job = jbegin + (int)blockIdx.x, buf = 0, nj2 = 0, kq = 0;
    if (TICKET) {
        if (tid == 0) { slot[0] = jbegin + (int)atomicAdd(ctr, 1u); slot[1] = jbegin + (int)atomicAdd(ctr, 1u); }
        __syncthreads();
        job = __builtin_amdgcn_readfirstlane(slot[0]); nj2 = __builtin_amdgcn_readfirstlane(slot[1]);
    }
    if (job >= jend) return;
    TJob cur = decode_job(p, job);
    f32x4 v[4]; float sc[4];
    tjob_load(cur, tid, v, sc);
    for (;;) {
        LAS bf16_t* T = (LAS bf16_t*)(lds + buf * (64 * TP * 2));
        if (TICKET) { if (tid == 0) slot[(kq + 2) & 3] = jbegin + (int)atomicAdd(ctr, 1u); }
        const int c4 = (tid & 15) * 4;
#pragma unroll
        for (int ps = 0; ps < 4; ++ps) { const int kk = (tid >> 4) + 32 * ps;
#pragma unroll
            for (int i = 0; i < 4; ++i) T[(c4 + i) * TP + kk] = (bf16_t)(cvt_pk_bf16(v[ps][i] * sc[ps], 0.f) & 0xffffu); }
        const int nj = TICKET ? nj2 : job + (int)gridDim.x; const bool more = nj < jend;
        TJob nxt = cur;
        if (more) { nxt = decode_job(p, nj); tjob_load(nxt, tid, v, sc); }
        __syncthreads();
        if (TICKET) nj2 = __builtin_amdgcn_readfirstlane(slot[(kq + 2) & 3]);
        { const int n = tid >> 3, kc = (tid & 7) * 16;
          const u32x4 w0 = *(const LAS u32x4*)(T + n * TP + kc), w1 = *(const LAS u32x4*)(T + n * TP + kc + 8);
          if (cur.f8) {
              u32x4 o;
#pragma unroll
              for (int i = 0; i < 2; ++i) { unsigned a = 0u, b = 0u;
                  a = __builtin_amdgcn_cvt_pk_fp8_f32(bf_lo(w0[2 * i]), bf_hi(w0[2 * i]), a, false); a = __builtin_amdgcn_cvt_pk_fp8_f32(bf_lo(w0[2 * i + 1]), bf_hi(w0[2 * i + 1]), a, true);
                  b = __builtin_amdgcn_cvt_pk_fp8_f32(bf_lo(w1[2 * i]), bf_hi(w1[2 * i]), b, false); b = __builtin_amdgcn_cvt_pk_fp8_f32(bf_lo(w1[2 * i + 1]), bf_hi(w1[2 * i + 1]), b, true);
                  o[i] = a; o[2 + i] = b; }
              *(u32x4*)((unsigned char*)cur.dst + (size_t)(cur.n0 + n) * cur.K + cur.k0 + kc) = o;
          } else {
              bf16_t* dp = cur.dst + (size_t)(cur.n0 + n) * cur.K + cur.k0 + kc;
              *(u32x4*)dp = w0; *(u32x4*)(dp + 8) = w1; } }
        if (!more) break;
        cur = nxt; job = nj; buf ^= 1; ++kq;
    }
}

__device__ __forceinline__ void conv_flat(const float* __restrict__ src, bf16_t* __restrict__ dst, size_t n, int wv) {
    const size_t nth = (size_t)gridDim.x * NTHREADS;
    for (size_t i = ((size_t)opaque_bid() * NTHREADS + opaque_tid(wv)) * 8; i < n; i += nth * 8) {
        const f32x4 a = __builtin_nontemporal_load((const f32x4*)(src + i)), b = __builtin_nontemporal_load((const f32x4*)(src + i + 4));
        u32x4 w; w.x = cvt_pk_bf16(a[0], a[1]); w.y = cvt_pk_bf16(a[2], a[3]); w.z = cvt_pk_bf16(b[0], b[1]); w.w = cvt_pk_bf16(b[2], b[3]);
        *(u32x4*)(dst + i) = w;
    }
}

__device__ __forceinline__ void conv_flat_fp4(const float* __restrict__ src, unsigned char* __restrict__ dst, size_t n, float scale, int wv) {
    const size_t nth = (size_t)gridDim.x * NTHREADS;
    for (size_t i = ((size_t)opaque_bid() * NTHREADS + opaque_tid(wv)) * 16; i < n; i += nth * 16) {
        u32x2 w;
#pragma unroll
        for (int q = 0; q < 2; ++q) {
            f32x4 a = __builtin_nontemporal_load((const f32x4*)(src + i + 8 * q)), b = __builtin_nontemporal_load((const f32x4*)(src + i + 8 * q + 4));
#pragma unroll
            for (int e = 0; e < 4; ++e) { a[e] = fminf(fmaxf(a[e] * scale, -6.0f), 6.0f); b[e] = fminf(fmaxf(b[e] * scale, -6.0f), 6.0f); }
            unsigned pk = 0u;
            pk = __builtin_amdgcn_cvt_scalef32_pk_fp4_f32(pk, a[0], a[1], 1.0f, 0);
            pk = __builtin_amdgcn_cvt_scalef32_pk_fp4_f32(pk, a[2], a[3], 1.0f, 1);
            pk = __builtin_amdgcn_cvt_scalef32_pk_fp4_f32(pk, b[0], b[1], 1.0f, 2);
            pk = __builtin_amdgcn_cvt_scalef32_pk_fp4_f32(pk, b[2], b[3], 1.0f, 3);
            w[q] = pk;
        }
        *(u32x2*)(dst + (i >> 1)) = w;
    }
}

__device__ __forceinline__ void rms_row_to_bf16(const float* __restrict__ xr, const float* __restrict__ g, bf16_t* __restrict__ hr, unsigned char* __restrict__ h8r, int lane) {
    const float4 a0 = *(const float4*)(xr + 8 * lane), a1 = *(const float4*)(xr + 8 * lane + 4);
    const float4 b0 = *(const float4*)(xr + 512 + 8 * lane), b1 = *(const float4*)(xr + 512 + 8 * lane + 4);
    float ss = a0.x * a0.x + a0.y * a0.y + a0.z * a0.z + a0.w * a0.w + a1.x * a1.x + a1.y * a1.y + a1.z * a1.z + a1.w * a1.w
             + b0.x * b0.x + b0.y * b0.y + b0.z * b0.z + b0.w * b0.w + b1.x * b1.x + b1.y * b1.y + b1.z * b1.z + b1.w * b1.w;
    ss = wave_sum(ss);
    const float rs = rsqrtf(ss * (1.0f / DM) + RMS_EPS);
    const float4 g0 = *(const float4*)(g + 8 * lane), g1 = *(const float4*)(g + 8 * lane + 4), g2 = *(const float4*)(g + 512 + 8 * lane), g3 = *(const float4*)(g + 512 + 8 * lane + 4);
    u32x4 w;
    w.x = cvt_pk_bf16(a0.x * rs * g0.x, a0.y * rs * g0.y); w.y = cvt_pk_bf16(a0.z * rs * g0.z, a0.w * rs * g0.w);
    w.z = cvt_pk_bf16(a1.x * rs * g1.x, a1.y * rs * g1.y); w.w = cvt_pk_bf16(a1.z * rs * g1.z, a1.w * rs * g1.w);
    *(u32x4*)(hr + 8 * lane) = w;
    { u32x2 o; unsigned a = 0u, b = 0u;
      a = __builtin_amdgcn_cvt_pk_fp8_f32(a0.x * rs * g0.x, a0.y * rs * g0.y, a, false); a = __builtin_amdgcn_cvt_pk_fp8_f32(a0.z * rs * g0.z, a0.w * rs * g0.w, a, true);
      b = __builtin_amdgcn_cvt_pk_fp8_f32(a1.x * rs * g1.x, a1.y * rs * g1.y, b, false); b = __builtin_amdgcn_cvt_pk_fp8_f32(a1.z * rs * g1.z, a1.w * rs * g1.w, b, true);
      o.x = a; o.y = b; *(u32x2*)(h8r + 8 * lane) = o;
      a = 0u; b = 0u;
      a = __builtin_amdgcn_cvt_pk_fp8_f32(b0.x * rs * g2.x, b0.y * rs * g2.y, a, false); a = __builtin_amdgcn_cvt_pk_fp8_f32(b0.z * rs * g2.z, b0.w * rs * g2.w, a, true);
      b = __builtin_amdgcn_cvt_pk_fp8_f32(b1.x * rs * g3.x, b1.y * rs * g3.y, b, false); b = __builtin_amdgcn_cvt_pk_fp8_f32(b1.z * rs * g3.z, b1.w * rs * g3.w, b, true);
      o.x = a; o.y = b; *(u32x2*)(h8r + 512 + 8 * lane) = o; }
    w.x = cvt_pk_bf16(b0.x * rs * g2.x, b0.y * rs * g2.y); w.y = cvt_pk_bf16(b0.z * rs * g2.z, b0.w * rs * g2.w);
    w.z = cvt_pk_bf16(b1.x * rs * g3.x, b1.y * rs * g3.y); w.w = cvt_pk_bf16(b1.z * rs * g3.z, b1.w * rs * g3.w);
    *(u32x4*)(hr + 512 + 8 * lane) = w;
}

__device__ __forceinline__ void phase_prologue(const Params& p, LAS unsigned char* lds, int wv) {
    const int tid = opaque_tid(wv), lane = tid & 63, wid = tid >> 6;
    if (blockIdx.x < 64) {
        const int lj = blockIdx.x >> 4, f = (blockIdx.x & 15) * 8 + (tid & 7), kg = tid >> 3;
        const float* pos = p.cmp_pos + (size_t)lj * 2048; const float* w1 = p.cmp_w1 + (size_t)lj * 2048 * 128;
        float s = 0.f;
#pragma unroll 8
        for (int i = 0; i < 32; ++i) { const int k = kg + 64 * i; s += pos[k] * w1[(size_t)k * 128 + f]; }
        LAS float* red = (LAS float*)(lds + 40960);
        red[tid] = s;
        __syncthreads();
        if (tid < 8) { float a = 0.f;
            for (int g = 0; g < 64; ++g) a += red[g * 8 + tid];
            ((float*)(p.ws + OFF_CBIAS))[lj * 128 + (blockIdx.x & 15) * 8 + tid] = a; }
    }
    conv_jobs<false>(p, lds, tid, 0, TJ_IN + TJ_VT, nullptr);
    __syncthreads();
    conv_jobs<false>(p, lds, tid, TJ_IN + TJ_VT + 3 * TJ_BR + TJ_OUT + TJ_Q, TJ_LAYER, nullptr);
    for (int l = 0; l < NLAYER; ++l) conv_flat(p.peer_keys + (size_t)l * 262144, (bf16_t*)(p.ws + OFF_W + (size_t)l * LW + W_KP), 262144, wv);
    for (int l = 0; l < 1; ++l) {
        conv_flat_fp4(p.peer_u + (size_t)l * 16384 * 1024, p.ws + OFF_U + (size_t)l * 16384 * 512, (size_t)16384 * 1024, U4_SCALE, wv);
        conv_flat_fp4(p.peer_v + (size_t)l * 16384 * 1024, p.ws + OFF_V + (size_t)l * 16384 * 512, (size_t)16384 * 1024, V4_SCALE, wv);
    }
    const int gw = blockIdx.x * 8 + wid, nw = gridDim.x * 8;
    for (int r = gw; r < S_LEN; r += nw) rms_row_to_bf16(p.x + (size_t)r * DM, p.norm1, (bf16_t*)(p.ws + OFF_H) + (size_t)r * DM, p.ws + OFF_H8 + (size_t)r * DM, lane);
}

__device__ __forceinline__ u32x4 pack_acc(const f32x4& v0, const f32x4& v1) {
    u32x4 w; w.x = cvt_pk_bf16(v0[0], v0[1]); w.y = cvt_pk_bf16(v0[2], v0[3]); w.z = cvt_pk_bf16(v1[0], v1[1]); w.w = cvt_pk_bf16(v1[2], v1[3]); return w;
}
struct EpiGate {
    static constexpr bool PERM = true, AFTER_DRAIN = false;
    unsigned char* g8;
    __device__ __forceinline__ void operator()(const f32x4 (&acc)[2][2][4][2], const pg8::Unit& u, int wr, int wc, int fr, int fq) const {
        __builtin_amdgcn_sched_barrier(0); asm volatile("s_nop 15\n\ts_nop 15" ::: "memory"); __builtin_amdgcn_sched_barrier(0);
        unsigned char* gp = g8 + ((((size_t)u.pm * 12 + u.pn) * 8 + (wr * 4 + wc)) * 8) * 1024 + (fq * 16 + fr) * 16;
        auto g8f = [](float v) { return fast_rcp(__builtin_fmaf(fast_exp2(v * (-LOG2E / WG_SCALE)), 1.0f / 255.0f, 1.0f / 255.0f)); };
#pragma unroll
        for (int ai = 0; ai < 2; ++ai)
#pragma unroll
            for (int m = 0; m < 4; ++m) {
                u32x4 w;
#pragma unroll
                for (int bj = 0; bj < 2; ++bj) { const f32x4 v0 = acc[ai][bj][m][0], v1 = acc[ai][bj][m][1];
                    unsigned w0 = 0u, w1 = 0u;
                    w0 = __builtin_amdgcn_cvt_pk_u8_f32(g8f(v0[0]), 0, w0); w0 = __builtin_amdgcn_cvt_pk_u8_f32(g8f(v0[1]), 1, w0);
                    w0 = __builtin_amdgcn_cvt_pk_u8_f32(g8f(v0[2]), 2, w0); w0 = __builtin_amdgcn_cvt_pk_u8_f32(g8f(v0[3]), 3, w0);
                    w1 = __builtin_amdgcn_cvt_pk_u8_f32(g8f(v1[0]), 0, w1); w1 = __builtin_amdgcn_cvt_pk_u8_f32(g8f(v1[1]), 1, w1);
                    w1 = __builtin_amdgcn_cvt_pk_u8_f32(g8f(v1[2]), 2, w1); w1 = __builtin_amdgcn_cvt_pk_u8_f32(g8f(v1[3]), 3, w1);
                    w[2 * bj] = w0; w[2 * bj + 1] = w1; }
                *(u32x4*)(gp + (ai * 4 + m) * 1024) = w; }
    }
};
struct EpiIn {
    static constexpr bool PERM = true, AFTER_DRAIN = false;
    bf16_t* qall; bf16_t* kall; bf16_t* rr;
    __device__ __forceinline__ void operator()(const f32x4 (&acc)[2][2][4][2], const pg8::Unit& u, int wr, int wc, int fr, int fq) const {
        const int row0 = u.pm * 256 + wr * 64 + fr;
#pragma unroll
        for (int bj = 0; bj < 2; ++bj) {
            const int col = u.pn * 256 + bj * 128 + wc * 32 + 8 * fq;
            if (col < 2432) {
                bf16_t* plane = (col < 1536) ? qall + (size_t)(col >> 6) * PLANE : kall + (size_t)((col - 1536) >> 6) * PLANE;
                const int d0 = col & 63, ks = d0 >> 4, hh = (d0 >> 3) & 1;
#pragma unroll
                for (int ai = 0; ai < 2; ++ai)
#pragma unroll
                    for (int m = 0; m < 4; ++m) { const int row = row0 + ai * 128 + m * 16;
                        *(u32x4*)(plane + ((size_t)((row >> 5) * 4 + ks) * 64 + (row & 31) + 32 * hh) * 8) = pack_acc(acc[ai][bj][m][0], acc[ai][bj][m][1]); }
            } else if (col < 2432 + RW) {
                const int c2 = col - 2432;
#pragma unroll
                for (int ai = 0; ai < 2; ++ai)
#pragma unroll
                    for (int m = 0; m < 4; ++m) { const int row = row0 + ai * 128 + m * 16;
                        *(u32x4*)(rr + (size_t)row * RW + c2) = pack_acc(acc[ai][bj][m][0], acc[ai][bj][m][1]); }
            }
        }
    }
};
struct EpiVT {
    static constexpr bool PERM = true, AFTER_DRAIN = false;
    bf16_t* vall;
    __device__ __forceinline__ void operator()(const f32x4 (&acc)[2][2][4][2], const pg8::Unit& u, int wr, int wc, int fr, int fq) const {
        const int row0 = u.pm * 256 + wr * 64 + fr;
#pragma unroll
        for (int ai = 0; ai < 2; ++ai)
#pragma unroll
            for (int m = 0; m < 4; ++m) { const int row = row0 + ai * 128 + m * 16; const int pl = row >> 6, d = row & 63, dt = d >> 5;
                if (pl < 14) {
                    bf16_t* plane = vall + (size_t)pl * PLANE;
#pragma unroll
                    for (int bj = 0; bj < 2; ++bj) { const int t0 = u.pn * 256 + bj * 128 + wc * 32 + 8 * fq; const int kk0 = t0 & 31, s = kk0 >> 4, j0 = ((kk0 >> 3) & 1) * 4;
                        bf16_t* base = plane + ((size_t)(((t0 >> 5) * 2 + dt) * 2 + s) * 64) * 8 + j0;
                        const f32x4 v0 = acc[ai][bj][m][0], v1 = acc[ai][bj][m][1];
                        u32x2 a; a.x = cvt_pk_bf16(v0[0], v0[1]); a.y = cvt_pk_bf16(v0[2], v0[3]);
                        u32x2 b; b.x = cvt_pk_bf16(v1[0], v1[1]); b.y = cvt_pk_bf16(v1[2], v1[3]);
                        *(u32x2*)(base + (size_t)(d & 31) * 8) = a;
                        *(u32x2*)(base + (size_t)((d & 31) + 32) * 8) = b; }
                } }
    }
};
template <int IDX> struct EpiMix {
    static constexpr bool PERM = true, AFTER_DRAIN = false;
    const unsigned char* g8; bf16_t* mixed;
    __device__ __forceinline__ void operator()(const f32x4 (&acc)[2][2][4][2], const pg8::Unit& u, int wr, int wc, int fr, int fq) const {
        const int row0 = u.pm * 256 + wr * 64 + fr;
        const unsigned char* gp = g8 + ((((size_t)u.pm * 12 + (IDX * 4 + u.pn)) * 8 + (wr * 4 + wc)) * 8) * 1024 + (fq * 16 + fr) * 16;
#pragma unroll
        for (int ai = 0; ai < 2; ++ai)
#pragma unroll
            for (int m = 0; m < 4; ++m) { const int row = row0 + ai * 128 + m * 16;
                const u32x4 gg = *(const u32x4*)(gp + (ai * 4 + m) * 1024);
#pragma unroll
                for (int bj = 0; bj < 2; ++bj) { const int col = u.pn * 256 + bj * 128 + wc * 32 + 8 * fq;
                    const unsigned gx = gg[2 * bj], gy = gg[2 * bj + 1];
                    const f32x4 v0 = acc[ai][bj][m][0], v1 = acc[ai][bj][m][1];
                    constexpr float Q = 1.0f / 255.0f;
                    float o[8];
                    o[0] = (float)(gx & 255u) * Q * v0[0]; o[1] = (float)((gx >> 8) & 255u) * Q * v0[1]; o[2] = (float)((gx >> 16) & 255u) * Q * v0[2]; o[3] = (float)(gx >> 24) * Q * v0[3];
                    o[4] = (float)(gy & 255u) * Q * v1[0]; o[5] = (float)((gy >> 8) & 255u) * Q * v1[1]; o[6] = (float)((gy >> 16) & 255u) * Q * v1[2]; o[7] = (float)(gy >> 24) * Q * v1[3];
                    bf16_t* mp = mixed + (size_t)row * DM + col;
                    if (IDX > 0) { const u32x4 pz = *(const u32x4*)mp;
                        o[0] += bf_lo(pz.x); o[1] += bf_hi(pz.x); o[2] += bf_lo(pz.y); o[3] += bf_hi(pz.y); o[4] += bf_lo(pz.z); o[5] += bf_hi(pz.z); o[6] += bf_lo(pz.w); o[7] += bf_hi(pz.w); }
                    u32x4 w; w.x = cvt_pk_bf16(o[0], o[1]); w.y = cvt_pk_bf16(o[2], o[3]); w.z = cvt_pk_bf16(o[4], o[5]); w.w = cvt_pk_bf16(o[6], o[7]);
                    *(u32x4*)mp = w; } }
    }
};
struct BranchOrder {
    pg8::StaticOrder so;
    __host__ __device__ void init(int G_, int c_) { so.init(S_LEN, 1024, G_, c_); }
    __host__ __device__ bool next(int i, pg8::Unit& u) const {
        const int r = i / 3, br = i - 3 * r;
        if (!so.next(r, u)) return false;
        u.pm += 64 * br; u.pn += 4 * br; return true;
    }
    __device__ __forceinline__ void a_ready(const pg8::Unit&) const {}
    __device__ __forceinline__ void done(const pg8::Unit&) const {}
};
struct EpiMix3 {
    static constexpr bool PERM = true, AFTER_DRAIN = false;
    const unsigned char* rr; bf16_t* mixed;
    __device__ __forceinline__ void operator()(const f32x4 (&acc)[2][2][4][2], const pg8::Unit& u, int wr, int wc, int fr, int fq) const {
        const int br = u.pn >> 2; pg8::Unit v; v.pm = u.pm - 64 * br; v.pn = u.pn & 3;
        if (br == 0) { EpiMix<0> e{rr, mixed}; e(acc, v, wr, wc, fr, fq); }
        else if (br == 1) { EpiMix<1> e{rr, mixed}; e(acc, v, wr, wc, fr, fq); }
        else { EpiMix<2> e{rr, mixed}; e(acc, v, wr, wc, fr, fq); }
    }
};
__device__ __forceinline__ float row_rstd(const float* rowss, int row) {
    const f32x4* pp = (const f32x4*)(rowss + (size_t)row * 16);
    const f32x4 a = pp[0], b = pp[1], c = pp[2], d = pp[3];
    const float s = ((a[0] + a[1]) + (a[2] + a[3])) + ((b[0] + b[1]) + (b[2] + b[3])) + ((c[0] + c[1]) + (c[2] + c[3])) + ((d[0] + d[1]) + (d[2] + d[3]));
    return rsqrtf(s * (1.0f / DM) + RMS_EPS);
}
template <bool BASE_BF16> struct EpiOut {
    static constexpr bool PERM = true, AFTER_DRAIN = false;
    const void* base; bf16_t* x1b; float* rowss; unsigned char* x8;
    __device__ __forceinline__ void operator()(const f32x4 (&acc)[2][2][4][2], const pg8::Unit& u, int wr, int wc, int fr, int fq) const {
        const int row0 = u.pm * 256 + wr * 64 + fr;
#pragma unroll
        for (int ai = 0; ai < 2; ++ai)
#pragma unroll
            for (int m = 0; m < 4; ++m) { const int row = row0 + ai * 128 + m * 16; float ss = 0.f;
#pragma unroll
                for (int bj = 0; bj < 2; ++bj) { const int col = u.pn * 256 + bj * 128 + wc * 32 + 8 * fq; const size_t off = (size_t)row * DM + col;
                    f32x4 b0, b1;
                    if (BASE_BF16) { const u32x4 w = *(const u32x4*)((const bf16_t*)base + off);
                        b0 = (f32x4){bf_lo(w.x), bf_hi(w.x), bf_lo(w.y), bf_hi(w.y)}; b1 = (f32x4){bf_lo(w.z), bf_hi(w.z), bf_lo(w.w), bf_hi(w.w)}; }
                    else { b0 = *(const f32x4*)((const float*)base + off); b1 = *(const f32x4*)((const float*)base + off + 4); }
                    const f32x4 x0 = b0 + acc[ai][bj][m][0], x1 = b1 + acc[ai][bj][m][1];
                    *(u32x4*)(x1b + off) = pack_acc(x0, x1);
                    { u32x2 o; unsigned a = 0u, b = 0u;
                      a = __builtin_amdgcn_cvt_pk_fp8_f32(x0[0] * X8_SCALE, x0[1] * X8_SCALE, a, false); a = __builtin_amdgcn_cvt_pk_fp8_f32(x0[2] * X8_SCALE, x0[3] * X8_SCALE, a, true);
                      b = __builtin_amdgcn_cvt_pk_fp8_f32(x1[0] * X8_SCALE, x1[1] * X8_SCALE, b, false); b = __builtin_amdgcn_cvt_pk_fp8_f32(x1[2] * X8_SCALE, x1[3] * X8_SCALE, b, true);
                      o.x = a; o.y = b; *(u32x2*)(x8 + off) = o; }
                    ss += x0[0] * x0[0] + x0[1] * x0[1] + x0[2] * x0[2] + x0[3] * x0[3] + x1[0] * x1[0] + x1[1] * x1[1] + x1[2] * x1[2] + x1[3] * x1[3]; }
                ss += __shfl_xor(ss, 16); ss += __shfl_xor(ss, 32);
                if (fq == 0) rowss[(size_t)row * 16 + u.pn * 4 + wc] = ss; }
    }
};
struct EpiQr {
    static constexpr bool PERM = true, AFTER_DRAIN = false;
    const float* rowss; bf16_t* qr;
    __device__ __forceinline__ void operator()(const f32x4 (&acc)[2][2][4][2], const pg8::Unit& u, int wr, int wc, int fr, int fq) const {
        const int row0 = u.pm * 256 + wr * 64 + fr;
#pragma unroll
        for (int ai = 0; ai < 2; ++ai)
#pragma unroll
            for (int m = 0; m < 4; ++m) { const int row = row0 + ai * 128 + m * 16; const float rs = row_rstd(rowss, row);
#pragma unroll
                for (int bj = 0; bj < 2; ++bj) { const int col = u.pn * 256 + bj * 128 + wc * 32 + 8 * fq;
                    const f32x4 v0 = acc[ai][bj][m][0] * rs, v1 = acc[ai][bj][m][1] * rs;
                    *(u32x4*)(qr + (size_t)row * 2048 + col) = pack_acc(v0, v1); } }
    }
};
struct Acc2 { f32x16 o0, o1; float m, l; };

__device__ __forceinline__ void load_q(bf16x8 (&qf)[4], const bf16_t* qplane, int qt, int row, int h) {
    const bf16x8* qp = (const bf16x8*)(qplane + (size_t)qt * 2048) + row + 32 * h;
#pragma unroll
    for (int ks = 0; ks < 4; ++ks) qf[ks] = qp[ks * 64];
}
struct Frag4 { bf16x8 a, b, c, d; };
__device__ __forceinline__ Frag4 load_frag4(const bf16_t* plane, int tile, int lane) {
    const bf16x8* fp = (const bf16x8*)(plane + (size_t)tile * 2048) + lane;
    Frag4 f; f.a = fp[0]; f.b = fp[64]; f.c = fp[128]; f.d = fp[192]; return f;
}
__device__ __forceinline__ bf16x8 alibi_a(int lane, int cm) {
    const unsigned b = __float_as_uint((float)(cm * (lane & 31))) >> 16;
    u32x4 w = {lane < 32 ? (b | (b << 16)) : 0u, 0u, 0u, 0u};
    return __builtin_bit_cast(bf16x8, w);
}
__device__ __forceinline__ bf16x8 alibi_b(int lane, float slope2) {
    const unsigned hi = __float_as_uint(slope2) & 0xffff0000u;
    const unsigned lo = __float_as_uint(slope2 - __uint_as_float(hi)) >> 16;
    u32x4 w = {lane < 32 ? ((hi >> 16) | (lo << 16)) : 0u, 0u, 0u, 0u};
    return __builtin_bit_cast(bf16x8, w);
}
__device__ __forceinline__ f32x16 qk_frag_b(const Frag4& k, const bf16x8 (&qf)[4], const bf16x8& ab, const bf16x8& qb) {
    f32x16 s = zero16();
    s = MFMA32(ab, qb, s);
    s = MFMA32(k.a, qf[0], s); s = MFMA32(k.b, qf[1], s); s = MFMA32(k.c, qf[2], s); s = MFMA32(k.d, qf[3], s);
    return s;
}
__device__ __forceinline__ f32x16 qk_frag(const Frag4& k, const bf16x8 (&qf)[4]) {
    f32x16 s = zero16();
    s = MFMA32(k.a, qf[0], s); s = MFMA32(k.b, qf[1], s); s = MFMA32(k.c, qf[2], s); s = MFMA32(k.d, qf[3], s);
    return s;
}
__device__ __forceinline__ void pv_frag(f32x16& o0, f32x16& o1, const Frag4& v, const float (&p)[16]) {
    const bf16x8 p0 = pack8(p[0], p[1], p[2], p[3], p[4], p[5], p[6], p[7]);
    const bf16x8 p1 = pack8(p[8], p[9], p[10], p[11], p[12], p[13], p[14], p[15]);
    o0 = MFMA32(v.a, p0, o0); o0 = MFMA32(v.b, p1, o0); o1 = MFMA32(v.c, p0, o1); o1 = MFMA32(v.d, p1, o1);
}
__device__ __forceinline__ float pair_max(float v) { const auto r = __builtin_amdgcn_permlane32_swap(__float_as_uint(v), __float_as_uint(v), false, false); return fmaxf(__uint_as_float(r[0]), __uint_as_float(r[1])); }
__device__ __forceinline__ float pair_sum(float v) { const auto r = __builtin_amdgcn_permlane32_swap(__float_as_uint(v), __float_as_uint(v), false, false); return __uint_as_float(r[0]) + __uint_as_float(r[1]); }
__device__ __forceinline__ float max16(const float (&y)[16]) {
    const float a = fmaxf(fmaxf(y[0], y[1]), fmaxf(y[2], y[3])), b = fmaxf(fmaxf(y[4], y[5]), fmaxf(y[6], y[7]));
    const float c = fmaxf(fmaxf(y[8], y[9]), fmaxf(y[10], y[11])), d = fmaxf(fmaxf(y[12], y[13]), fmaxf(y[14], y[15]));
    return fmaxf(fmaxf(a, b), fmaxf(c, d));
}
template <int CM, int KS, bool MASK> __device__ __forceinline__ void tile_logits(float (&y)[16], const f32x16& s, const float slope2, int lo, int hi) {
#pragma unroll
    for (int r = 0; r < 16; ++r) { float v = s[r];
        if (MASK) v = (KS * ROWOFF(r) <= hi && KS * ROWOFF(r) > lo) ? v : NEGV;
        y[r] = v; }
}
__device__ __forceinline__ void sm_step(Acc2& a, const float (&y)[16], float b0, const Frag4& v) {
    const float mt = pair_max(max16(y) + b0);
    if (__any(mt > a.m + 8.0f)) { const float mn = fmaxf(a.m, mt), al = fast_exp2(a.m - mn); a.o0 *= al; a.o1 *= al; a.l *= al; a.m = mn; }
    const float off = b0 - a.m;
    float p[16]; float ps = 0.f;
#pragma unroll
    for (int r = 0; r < 16; ++r) { p[r] = fast_exp2(y[r] + off); ps += p[r]; }
    a.l += ps;
    pv_frag(a.o0, a.o1, v, p);
}
__device__ __forceinline__ void store_o(bf16_t* obuf, int t, int hd, const f32x16& o0, const f32x16& o1, float sc, int lane) {
    const int h = lane >> 5;
    bf16_t* rowp = obuf + (size_t)t * 512 + hd * 64 + 4 * h;
#pragma unroll
    for (int i = 0; i < 4; ++i) {
        u32x2 w; w.x = cvt_pk_bf16(o0[4 * i] * sc, o0[4 * i + 1] * sc); w.y = cvt_pk_bf16(o0[4 * i + 2] * sc, o0[4 * i + 3] * sc);
        *(u32x2*)(rowp + 8 * i) = w;
        u32x2 z; z.x = cvt_pk_bf16(o1[4 * i] * sc, o1[4 * i + 1] * sc); z.y = cvt_pk_bf16(o1[4 * i + 2] * sc, o1[4 * i + 3] * sc);
        *(u32x2*)(rowp + 32 + 8 * i) = z;
    }
}

__device__ __forceinline__ void store_o_lds(LAS unsigned char* stg, bf16_t* obuf, int qt, int hd, const f32x16& o0, const f32x16& o1, float sc, int lane) {
    constexpr int OP = 144;
    const int h = lane >> 5;
    LAS unsigned char* wp = stg + (lane & 31) * OP + 8 * h;
#pragma unroll
    for (int i = 0; i < 4; ++i) {
        u32x2 w; w.x = cvt_pk_bf16(o0[4 * i] * sc, o0[4 * i + 1] * sc); w.y = cvt_pk_bf16(o0[4 * i + 2] * sc, o0[4 * i + 3] * sc);
        *(LAS u32x2*)(wp + 16 * i) = w;
        u32x2 z; z.x = cvt_pk_bf16(o1[4 * i] * sc, o1[4 * i + 1] * sc); z.y = cvt_pk_bf16(o1[4 * i + 2] * sc, o1[4 * i + 3] * sc);
        *(LAS u32x2*)(wp + 64 + 16 * i) = z;
    }
    __builtin_amdgcn_wave_barrier();
    bf16_t* ob = obuf + (size_t)(qt * 32) * 512 + hd * 64 + 8 * (lane & 7);
#pragma unroll
    for (int j = 0; j < 4; ++j) { const int row = (lane >> 3) + 8 * j;
        const u32x4 v = *(LAS const u32x4*)(stg + row * OP + 16 * (lane & 7));
        *(u32x4*)(ob + (size_t)row * 512) = v; }
    __builtin_amdgcn_wave_barrier();
}
template <int W, bool PF> __device__ __forceinline__ void banded_loop(Acc2& a, const bf16x8 (&qf)[4], const bf16x8& ab, const bf16x8& qb, float slope2, int t, int h,
                                                             const bf16_t* kplane, const bf16_t* vplane, int kt_hi, int kt_lo, int lane) {
    Frag4 k0, k1, v0, v1;
    k0 = load_frag4(kplane, kt_hi, lane);
    if (PF) v0 = load_frag4(vplane, kt_hi, lane);
#define BL_STEP(kc_, vc_, kn_, vn_, kt_) do { const int kt__ = (kt_); \
        const int ktn = kt__ > kt_lo ? kt__ - 1 : kt__;                   \
        kn_ = load_frag4(kplane, ktn, lane); \
        if (PF) vn_ = load_frag4(vplane, ktn, lane); else vc_ = load_frag4(vplane, kt__, lane);        \
        const f32x16 s = qk_frag_b(kc_, qf, ab, qb); \
        const int dbase = t - (kt__ * 32 + 4 * h);                        \
        float y[16]; \
        if (kt__ == kt_hi || kt__ * 32 + W <= kt_hi * 32 + 31) tile_logits<1, 1, true>(y, s, slope2, dbase - W, dbase);      \
        else tile_logits<1, 1, false>(y, s, slope2, 0, 0); \
        sm_step(a, y, -slope2 * (float)(dbase + 4 * h), vc_); } while (0)
#pragma unroll 1
    for (int kt = kt_hi; kt >= kt_lo; kt -= 2) {
        BL_STEP(k0, v0, k1, v1, kt);
        if (kt - 1 < kt_lo) break;
        BL_STEP(k1, v1, k0, v0, kt - 1);
    }
#undef BL_STEP
}

__device__ __forceinline__ void swa_unit(const Params& p, int layer, int qt, int hd, int lane, LAS unsigned char* stg) {
    const bf16_t* qplane = (const bf16_t*)(p.ws + OFF_QALL) + (size_t)hd * PLANE;
    const bf16_t* kplane = (const bf16_t*)(p.ws + OFF_KALL) + (size_t)(hd >> 2) * PLANE;
    const bf16_t* vplane = (const bf16_t*)(p.ws + OFF_VALL) + (size_t)(hd >> 2) * PLANE;
    const int h = lane >> 5, t = qt * 32 + (lane & 31);
    const float slope2 = fast_exp2(-(float)(hd + 1)) * LOG2E;
    bf16x8 qf[4]; load_q(qf, qplane, qt, lane & 31, h);
    Acc2 a; a.o0 = zero16(); a.o1 = zero16(); a.m = p.sinks[layer * 8 + hd] * LOG2E; a.l = h == 0 ? 1.0f : 0.0f;
    banded_loop<128, true>(a, qf, alibi_a(lane, 1), alibi_b(lane, slope2), slope2, t, h, kplane, vplane, qt, qt - 4 < 0 ? 0 : qt - 4, lane);
    store_o_lds(stg, (bf16_t*)(p.ws + OFF_OA), qt, hd, a.o0, a.o1, fast_rcp(pair_sum(a.l)), lane);
}

__device__ __forceinline__ void stick_unit(const Params& p, int qt, int hd, int lane, LAS unsigned char* stg) {
    const bf16_t* qplane = (const bf16_t*)(p.ws + OFF_QALL) + (size_t)(16 + hd) * PLANE;
    const bf16_t* kplane = (const bf16_t*)(p.ws + OFF_KALL) + (size_t)(6 + hd) * PLANE;
    const bf16_t* vplane = (const bf16_t*)(p.ws + OFF_VALL) + (size_t)(6 + hd) * PLANE;
    const int h = lane >> 5, t = qt * 32 + (lane & 31);
    bf16x8 qf[4]; load_q(qf, qplane, qt, lane & 31, h);
    f32x16 o0 = zero16(), o1 = zero16();
    float accl = 0.f;
    Frag4 k0 = load_frag4(kplane, qt, lane), v0 = load_frag4(vplane, qt, lane), k1, v1;
    bool done = false;
#define SB_STEP(kc_, vc_, kn_, vn_, kt_) do { const int kt__ = (kt_); \
        const int ktn = kt__ > 0 ? kt__ - 1 : 0; \
        kn_ = load_frag4(kplane, ktn, lane); vn_ = load_frag4(vplane, ktn, lane); \
        const f32x16 z = qk_frag(kc_, qf); \
        const int lim = t - (kt__ * 32 + 4 * h);             \
        float L[16], lb[16]; \
_Pragma("unroll") \
        for (int r = 0; r < 16; ++r) { \
            const float zz = z[r]; \
            const float sp = fmaxf(zz, 0.f) + __builtin_amdgcn_logf(1.0f + fast_exp2(-fabsf(zz)));     \
            const bool valid = (kt__ < qt) || (ROWOFF(r) < lim); \
            L[r] = valid ? -sp : 0.f;                      \
            lb[r] = valid ? zz - sp : NEGV;                \
        } \
        float G[4], Gp[4]; \
_Pragma("unroll") \
        for (int i = 0; i < 4; ++i) { G[i] = (L[4 * i] + L[4 * i + 1]) + (L[4 * i + 2] + L[4 * i + 3]); Gp[i] = pair_sum(G[i]) - G[i]; } \
        float a[16]; float run = 0.f; \
_Pragma("unroll") \
        for (int i = 3; i >= 0; --i) { \
            float w = accl + run + (h == 0 ? Gp[i] : 0.f);     \
_Pragma("unroll") \
            for (int e = 3; e >= 0; --e) { const int r = 4 * i + e; a[r] = fast_exp2(lb[r] + w); w += L[r]; } \
            run += G[i] + Gp[i]; \
        } \
        accl += run; \
        pv_frag(o0, o1, vc_, a); \
        if (__all(accl < -110.0f * LOG2E)) done = true;          \
    } while (0)
#pragma unroll 1
    for (int kt = qt; kt >= 0; kt -= 2) {
        SB_STEP(k0, v0, k1, v1, kt);
        if (done || kt - 1 < 0) break;
        SB_STEP(k1, v1, k0, v0, kt - 1);
        if (done) break;
    }
#undef SB_STEP
    store_o_lds(stg, (bf16_t*)(p.ws + OFF_OC), qt, hd, o0, o1, 1.0f, lane);
}

__device__ __forceinline__ void compress_unit(const Params& p, int layer, int cu, int wid, int lane, LAS unsigned char* lds) {
    const int j = cu >> 6, head = (cu >> 5) & 1, rt = cu & 31;
    const unsigned char* wl = p.ws + OFF_W + (size_t)layer * LW;
    const bf16_t* w1t = (const bf16_t*)(wl + W_1T) + (size_t)j * 128 * 2048;
    const bf16_t* w2t = (const bf16_t*)(wl + W_2T) + (size_t)j * 64 * 128;
    const float* cb = (const float*)(p.ws + OFF_CBIAS) + (layer * 2 + j) * 128;
    const bf16_t* rr = (const bf16_t*)(p.ws + OFF_R);
    const int h = lane >> 5, c = rt * 32 + (lane & 31);
    const int cc = c < 1023 ? c : 1022;
    LAS float* part = (LAS float*)lds;
    LAS u32x4* hfrag = (LAS u32x4*)(lds + 131072);
    {
        const bf16_t* xbase = rr + (size_t)(16 * cc) * RW + (j == 0 ? R_KCB : R_VCB) + head * 64 + 8 * h;
        const bf16_t* wbase = w1t + (size_t)(lane & 31) * 2048 + 8 * h;
        f32x16 acc[4];
#pragma unroll
        for (int ft = 0; ft < 4; ++ft) acc[ft] = zero16();
#pragma unroll 4
        for (int kk = 0; kk < 16; ++kk) { const int ks = wid * 16 + kk;
            const bf16x8 b = *(const bf16x8*)(xbase + (size_t)(ks >> 2) * RW + 16 * (ks & 3));
#pragma unroll
            for (int ft = 0; ft < 4; ++ft) { const bf16x8 a = *(const bf16x8*)(wbase + (size_t)ft * 32 * 2048 + 16 * ks); acc[ft] = MFMA32(a, b, acc[ft]); }
        }
#pragma unroll
        for (int ft = 0; ft < 4; ++ft)
#pragma unroll
            for (int r = 0; r < 16; ++r) part[((wid * 4 + ft) * 16 + r) * 64 + lane] = acc[ft][r];
    }
    __syncthreads();
    if (wid < 4) {
        const int ft = wid; float g[16];
#pragma unroll
        for (int r = 0; r < 16; ++r) { float s = 0.f;
#pragma unroll
            for (int w = 0; w < 8; ++w) s += part[((w * 4 + ft) * 16 + r) * 64 + lane];
            g[r] = gelu_tanh(s + cb[ft * 32 + ROWOFF(r) + 4 * h]); }
        hfrag[(ft * 2 + 0) * 64 + lane] = __builtin_bit_cast(u32x4, pack8(g[0], g[1], g[2], g[3], g[4], g[5], g[6], g[7]));
        hfrag[(ft * 2 + 1) * 64 + lane] = __builtin_bit_cast(u32x4, pack8(g[8], g[9], g[10], g[11], g[12], g[13], g[14], g[15]));
    }
    __syncthreads();
    if (wid < 2) {
        const int dt = wid; f32x16 o = zero16();
#pragma unroll
        for (int ft = 0; ft < 4; ++ft) {
            const bf16_t* wr_ = w2t + (size_t)(dt * 32 + (lane & 31)) * 128 + ft * 32 + 4 * h;
            u32x4 a0, a1;
            { const u32x2 lo = *(const u32x2*)(wr_), hi = *(const u32x2*)(wr_ + 8); a0.x = lo.x; a0.y = lo.y; a0.z = hi.x; a0.w = hi.y; }
            { const u32x2 lo = *(const u32x2*)(wr_ + 16), hi = *(const u32x2*)(wr_ + 24); a1.x = lo.x; a1.y = lo.y; a1.z = hi.x; a1.w = hi.y; }
            const u32x4 p0 = hfrag[(ft * 2 + 0) * 64 + lane], p1 = hfrag[(ft * 2 + 1) * 64 + lane];
            o = MFMA32(__builtin_bit_cast(bf16x8, a0), __builtin_bit_cast(bf16x8, p0), o);
            o = MFMA32(__builtin_bit_cast(bf16x8, a1), __builtin_bit_cast(bf16x8, p1), o);
        }
        const float keep = c < 1023 ? 1.0f : 0.0f;
        if (j == 0) {
            bf16_t* plane = (bf16_t*)(p.ws + OFF_KCMP) + (size_t)head * 65536;
#pragma unroll
            for (int i = 0; i < 4; ++i) { const int d0 = 32 * dt + 8 * i + 4 * h, ks = d0 >> 4, hh = (d0 >> 3) & 1, j0 = d0 & 7;
                u32x2 w; w.x = cvt_pk_bf16(o[4 * i] * keep, o[4 * i + 1] * keep); w.y = cvt_pk_bf16(o[4 * i + 2] * keep, o[4 * i + 3] * keep);
                *(u32x2*)(plane + ((size_t)((c >> 5) * 4 + ks) * 64 + (c & 31) + 32 * hh) * 8 + j0) = w; }
        } else {
            bf16_t* plane = (bf16_t*)(p.ws + OFF_VCMP) + (size_t)head * 65536;
            const int kk = c & 31, s = kk >> 4, r15 = kk & 15, jj = ((r15 >> 3) << 2) | (r15 & 3), hh = (r15 >> 2) & 1;
#pragma unroll
            for (int r = 0; r < 16; ++r) { const int d = 32 * dt + ROWOFF(r) + 4 * h;
                plane[((size_t)(((c >> 5) * 2 + dt) * 2 + s) * 64 + (d & 31) + 32 * hh) * 8 + jj] = (bf16_t)(cvt_pk_bf16(o[r] * keep, 0.f) & 0xffffu); }
        }
    }
    __syncthreads();
}

__device__ __forceinline__ void phase2_compress(const Params& p, int layer, LAS unsigned char* lds, int wv) {
    const int tid = opaque_tid(wv), lane = tid & 63, wid = tid >> 6;
    for (int u = opaque_bid(); u < 128; u += gridDim.x) compress_unit(p, layer, u, wid, lane, lds);
}
__device__ __forceinline__ void phase2_attn(const Params& p, int layer, LAS unsigned char* lds, int wv, int T8, int j8, int NT8) {
    const int tid = opaque_tid(wv), lane = tid & 63, wid = tid >> 6;
    for (int ui = 0; T8 + (ui >> 1) * NT8 < 32; ++ui) {
        const int pr = T8 + (ui >> 1) * NT8;
        const int qt = (ui & 1) ? 8 * (63 - pr) + 7 - j8 : 8 * pr + j8;
        swa_unit(p, layer, qt, wid, lane, lds + wid * 4608); stick_unit(p, qt, wid, lane, lds + wid * 4608);
    }
}

constexpr int IMP_PITCH = 257;
constexpr int P3_SEL = 2 * 32 * IMP_PITCH * 4;
constexpr int P3_SELU = P3_SEL + 2 * 32 * 8 * 4;
constexpr int P3_LISTS = P3_SELU + 256;
static_assert(P3_LISTS + 8 * 64 * 16 * 4 <= XB_LDS_OFF, "phase 3 LDS map");
__device__ __forceinline__ void phase3(const Params& p, int layer, LAS unsigned char* lds, int wv, int T8, int j8, int NT8) {
    const int tid = opaque_tid(wv), lane = tid & 63, wid = tid >> 6, h = lane >> 5, col = lane & 31;
    const int grp = wid >> 2, qi = 8 * (wid & 3) + (col >> 2), hd = grp * 4 + (col & 3);
    LAS float* imp = (LAS float*)lds;
    LAS unsigned* sel = (LAS unsigned*)(lds + P3_SEL);
    LAS unsigned* selu = (LAS unsigned*)(lds + P3_SELU);
    LAS unsigned* lists = (LAS unsigned*)(lds + P3_LISTS);
    const bf16_t* qplane = (const bf16_t*)(p.ws + OFF_QALL) + (size_t)(8 + hd) * PLANE;
    const bf16_t* kcmp = (const bf16_t*)(p.ws + OFF_KCMP) + (size_t)grp * 65536;
    const bf16_t* vcmp = (const bf16_t*)(p.ws + OFF_VCMP) + (size_t)grp * 65536;
    const bf16_t* kslc = (const bf16_t*)(p.ws + OFF_KALL) + (size_t)(2 + grp) * PLANE;
    const bf16_t* vslc = (const bf16_t*)(p.ws + OFF_VALL) + (size_t)(2 + grp) * PLANE;
    const bf16_t* kwin = (const bf16_t*)(p.ws + OFF_KALL) + (size_t)(4 + grp) * PLANE;
    const bf16_t* vwin = (const bf16_t*)(p.ws + OFF_VALL) + (size_t)(4 + grp) * PLANE;
    const bf16_t* rr = (const bf16_t*)(p.ws + OFF_R);
    const float slope2 = fast_exp2(-(float)(hd + 1)) * LOG2E;
    const bf16x8 qbias = alibi_b(lane, slope2);
    for (int ui = 0; T8 + (ui >> 1) * NT8 < 32; ++ui) {
        const int pr = T8 + (ui >> 1) * NT8;
        const int qt = (ui & 1) ? 8 * (63 - pr) + 7 - j8 : 8 * pr + j8;
        const int t = qt * 32 + qi;
        __syncthreads();
        for (int i = tid; i < 2 * 32 * IMP_PITCH; i += NTHREADS) imp[i] = 0.f;
        __syncthreads();
        bf16x8 qf[4]; load_q(qf, qplane, qt, qi, h);
        const bf16_t* gbp = rr + (size_t)t * RW + R_GB + hd * 3;
        const float g0 = sigmoidf_(__uint_as_float((unsigned)gbp[0] << 16)), g1 = sigmoidf_(__uint_as_float((unsigned)gbp[1] << 16)), g2 = sigmoidf_(__uint_as_float((unsigned)gbp[2] << 16));
        f32x16 ob0, ob1;
        const int ctmax = qt >> 4;
        float m = -1e4f, l = 0.f;
        {
            Frag4 kc = load_frag4(kcmp, ctmax, lane);
#pragma unroll 1
            for (int ct = ctmax; ct >= 0; --ct) {
                const Frag4 kn = load_frag4(kcmp, ct > 0 ? ct - 1 : 0, lane);
                const f32x16 s = qk_frag_b(kc, qf, alibi_a(lane, 16), qbias);
                const int dbase = t - 31 - 16 * (ct * 32 + 4 * h);
                float y[16];
                if (ct >= ctmax - 1) tile_logits<16, 16, true>(y, s, slope2, -(1 << 30), dbase); else tile_logits<16, 16, false>(y, s, slope2, 0, 0);
                const float b0 = -slope2 * (float)(dbase + 64 * h);
                const float mt = pair_max(max16(y) + b0);
                if (__any(mt > m + 8.0f)) { const float mn = fmaxf(m, mt); l *= fast_exp2(m - mn); m = mn; }
                const float off = b0 - m; float ps = 0.f;
#pragma unroll
                for (int r = 0; r < 16; ++r) ps += fast_exp2(y[r] + off);
                l += ps;
                kc = kn;
            }
            l = pair_sum(l);
        }
        {
            const float il = l > 0.f ? fast_rcp(l) : 0.f;
            f32x16 o0 = zero16(), o1 = zero16();
            LAS float* impq = imp + (grp * 32 + qi) * IMP_PITCH;
            Frag4 kc = load_frag4(kcmp, ctmax, lane);
#pragma unroll 1
            for (int ct = ctmax; ct >= 0; --ct) {
                const Frag4 kn = load_frag4(kcmp, ct > 0 ? ct - 1 : 0, lane), vc = load_frag4(vcmp, ct, lane);
                const f32x16 s = qk_frag_b(kc, qf, alibi_a(lane, 16), qbias);
                const int dbase = t - 31 - 16 * (ct * 32 + 4 * h);
                float y[16];
                if (ct >= ctmax - 1) tile_logits<16, 16, true>(y, s, slope2, -(1 << 30), dbase); else tile_logits<16, 16, false>(y, s, slope2, 0, 0);
                const float off = -slope2 * (float)(dbase + 64 * h) - m;
                float pr[16];
#pragma unroll
                for (int r = 0; r < 16; ++r) pr[r] = fast_exp2(y[r] + off) * il;
                pv_frag(o0, o1, vc, pr);
#pragma unroll
                for (int i = 0; i < 4; ++i) { const int jb = ct * 8 + 2 * i + h;
                    float gs = (pr[4 * i] + pr[4 * i + 1]) + (pr[4 * i + 2] + pr[4 * i + 3]), g3 = pr[4 * i + 3];
                    gs += dpp_f<0xB1>(gs); gs += dpp_f<0x4E>(gs); g3 += dpp_f<0xB1>(g3); g3 += dpp_f<0x4E>(g3);
                    if ((col & 3) == 0) { impq[jb] += gs; if (jb + 1 < 256) impq[jb + 1] += g3; } }
                kc = kn;
            }
            ob0 = o0 * g0; ob1 = o1 * g0;
        }
        __syncthreads();
        {
            const int sg = lane >> 5, sq = lane & 31, st = qt * 32 + sq, tb = st >> 6;
            const int tbmax = (qt * 32 + 31) >> 6;
            LAS const float* ip = imp + (sg * 32 + sq) * IMP_PITCH;
            unsigned lst[16];
#pragma unroll
            for (int i = 0; i < 16; ++i) lst[i] = 0u;
            const int jb_hi = (32 * wid + 31 < tbmax) ? 32 * wid + 31 : tbmax;
#pragma unroll 1
            for (int jb = 32 * wid; jb <= jb_hi; ++jb) {
                const float v = ip[jb];
                unsigned key = (__float_as_uint(v) & 0xffffff00u) | (unsigned)(255 - jb);
                if (jb == 0 || jb == tb || jb == tb - 1) key = 0xffffff00u | (unsigned)(255 - jb);
                if (jb > tb) key = 0u;
                top16_insert(lst, key);
            }
#pragma unroll
            for (int rd = 4; rd >= 1; rd >>= 1) {
                if (wid >= rd && wid < 2 * rd) {
#pragma unroll
                    for (int i = 0; i < 16; ++i) lists[(wid * 64 + lane) * 16 + i] = lst[i]; }
                __syncthreads();
                if (wid < rd) {
#pragma unroll 1
                    for (int i = 0; i < 16; ++i) top16_insert(lst, lists[((wid + rd) * 64 + lane) * 16 + i]); }
            }
            if (wid == 0) {
                unsigned wds[8];
#pragma unroll
                for (int w = 0; w < 8; ++w) wds[w] = 0u;
#pragma unroll
                for (int i = 0; i < 16; ++i) { const unsigned jb = 255u - (lst[i] & 255u); const unsigned bit = lst[i] ? (1u << (jb & 31u)) : 0u;
#pragma unroll
                    for (int w = 0; w < 8; ++w) wds[w] |= ((jb >> 5) == (unsigned)w) ? bit : 0u; }
                LAS unsigned* sp = sel + (sg * 32 + sq) * 8;
#pragma unroll
                for (int w = 0; w < 8; ++w) {
                    sp[w] = wds[w];
                    unsigned u = wds[w];
                    u |= dpp_u<0xB1>(u); u |= dpp_u<0x4E>(u); u |= dpp_u<0x141>(u); u |= dpp_u<0x140>(u);
                    const unsigned u0 = (unsigned)__builtin_amdgcn_readlane((int)u, 0) | (unsigned)__builtin_amdgcn_readlane((int)u, 16);
                    const unsigned u1 = (unsigned)__builtin_amdgcn_readlane((int)u, 32) | (unsigned)__builtin_amdgcn_readlane((int)u, 48);
                    if (lane == 0) { selu[w] = u0; selu[8 + w] = u1; }
                }
            }
        }
        __syncthreads();
        {
            Acc2 a; a.o0 = zero16(); a.o1 = zero16(); a.m = -1e4f; a.l = 0.f;
            LAS const unsigned* sp = sel + (grp * 32 + qi) * 8;
            LAS const unsigned* up = selu + grp * 8;
            int w = 7; unsigned bits = (unsigned)__builtin_amdgcn_readfirstlane((int)up[7]);
            while (bits == 0u && w > 0) { --w; bits = (unsigned)__builtin_amdgcn_readfirstlane((int)up[w]); }
            int jb = w * 32 + 31 - __builtin_clz(bits); bits &= ~(1u << (jb & 31));
            int kt = 2 * jb + 1;
            Frag4 kc = load_frag4(kslc, kt, lane);
            const int tb_lo = (qt * 32) >> 6;
            bool more = true;
#pragma unroll 1
            while (more) {
                int ktn = kt - 1, jbn = jb;
                if (!(kt & 1)) {
                    while (bits == 0u && w > 0) { --w; bits = (unsigned)__builtin_amdgcn_readfirstlane((int)up[w]); }
                    if (bits != 0u) { jbn = w * 32 + 31 - __builtin_clz(bits); bits &= ~(1u << (jbn & 31)); ktn = 2 * jbn + 1; }
                    else { more = false; ktn = kt; }
                }
                const Frag4 kn = load_frag4(kslc, ktn, lane), vc = load_frag4(vslc, kt, lane);
                const bool mine = (sp[jb >> 5] >> (jb & 31)) & 1u;
                const f32x16 s = qk_frag_b(kc, qf, alibi_a(lane, 1), qbias);
                const int dbase = t - (kt * 32 + 4 * h);
                float y[16];
                if (jb >= tb_lo) tile_logits<1, 1, true>(y, s, slope2, -(1 << 30), dbase); else tile_logits<1, 1, false>(y, s, slope2, 0, 0);
                sm_step(a, y, mine ? -slope2 * (float)(dbase + 4 * h) : NEGV, vc);
                kc = kn; kt = ktn; jb = jbn;
            }
            const float sc = g1 * fast_rcp(pair_sum(a.l));
            ob0 += a.o0 * sc; ob1 += a.o1 * sc;
        }
        {
            Acc2 a; a.o0 = zero16(); a.o1 = zero16(); a.m = -1e4f; a.l = 0.f;
            banded_loop<512, false>(a, qf, alibi_a(lane, 1), qbias, slope2, t, h, kwin, vwin, qt, qt - 16 < 0 ? 0 : qt - 16, lane);
            const float sc = g2 * fast_rcp(pair_sum(a.l));
            ob0 += a.o0 * sc; ob1 += a.o1 * sc;
        }
        {
            constexpr int OP = 528;
            LAS unsigned char* stg = lds + wid * (8 * OP);
            LAS unsigned char* wp = stg + (col >> 2) * OP + (col & 3) * 128 + 8 * h;
#pragma unroll
            for (int i = 0; i < 4; ++i) {
                u32x2 w; w.x = cvt_pk_bf16(ob0[4 * i], ob0[4 * i + 1]); w.y = cvt_pk_bf16(ob0[4 * i + 2], ob0[4 * i + 3]);
                *(LAS u32x2*)(wp + 16 * i) = w;
                u32x2 z; z.x = cvt_pk_bf16(ob1[4 * i], ob1[4 * i + 1]); z.y = cvt_pk_bf16(ob1[4 * i + 2], ob1[4 * i + 3]);
                *(LAS u32x2*)(wp + 64 + 16 * i) = z;
            }
            __builtin_amdgcn_wave_barrier();
            bf16_t* ob = (bf16_t*)(p.ws + OFF_OB) + (size_t)(qt * 32 + 8 * (wid & 3)) * 512 + grp * 256 + 8 * (lane & 31);
#pragma unroll
            for (int j = 0; j < 4; ++j) { const int qw = (lane >> 5) + 2 * j;
                const u32x4 v = *(LAS const u32x4*)(stg + qw * OP + 16 * (lane & 31));
                *(u32x4*)(ob + (size_t)qw * 512) = v; }
            __builtin_amdgcn_wave_barrier();
        }
    }
}

__device__ __forceinline__ void peer_half_top16(const bf16_t* qr, const bf16_t* kp, int t0, int hd, int half, int lane, unsigned (&lst)[16]) {
    const int h = lane >> 5, tl = lane & 31;
    f32x16 sT[4];
#pragma unroll
    for (int nt = 0; nt < 4; ++nt) sT[nt] = zero16();
    const bf16_t* qb = qr + (size_t)(t0 + tl) * 2048 + hd * 256 + half * 128 + 8 * h;
    const bf16_t* kb = kp + ((size_t)(half * 8 + hd) * 128 + tl) * 128 + 8 * h;
#pragma unroll 2
    for (int ks = 0; ks < 8; ++ks) {
        const bf16x8 b = *(const bf16x8*)(qb + 16 * ks);
#pragma unroll
        for (int nt = 0; nt < 4; ++nt) { const bf16x8 a = *(const bf16x8*)(kb + (size_t)nt * 32 * 128 + 16 * ks); sT[nt] = MFMA32(a, b, sT[nt]); }
    }
#pragma unroll
    for (int i = 0; i < 16; ++i) lst[i] = 0u;
#pragma unroll
    for (int nt = 0; nt < 4; ++nt)
#pragma unroll
        for (int r = 0; r < 16; ++r) { const unsigned n = (unsigned)(nt * 32 + ROWOFF(r) + 4 * h); top16_insert(lst, (f2ord(sT[nt][r]) & 0xffffff80u) | n); }
    unsigned oth[16];
#pragma unroll
    for (int i = 0; i < 16; ++i) oth[i] = (unsigned)__shfl_xor((int)lst[i], 32);
#pragma unroll
    for (int i = 0; i < 16; ++i) top16_insert(lst, oth[i]);
}

#define PK_CE(x_, i_, j_) do { const float hi_ = __builtin_amdgcn_fmed3f(x_[i_], x_[j_], __builtin_inff()), lo_ = __builtin_amdgcn_fmed3f(x_[i_], x_[j_], -__builtin_inff()); x_[i_] = hi_; x_[j_] = lo_; } while (0)
__device__ __forceinline__ void sort16_desc(float (&x)[16]) {
    PK_CE(x, 0, 1); PK_CE(x, 2, 3); PK_CE(x, 0, 2); PK_CE(x, 1, 3); PK_CE(x, 1, 2); PK_CE(x, 4, 5); PK_CE(x, 6, 7); PK_CE(x, 4, 6);
    PK_CE(x, 5, 7); PK_CE(x, 5, 6); PK_CE(x, 0, 4); PK_CE(x, 2, 6); PK_CE(x, 2, 4); PK_CE(x, 1, 5); PK_CE(x, 3, 7); PK_CE(x, 3, 5);
    PK_CE(x, 1, 2); PK_CE(x, 3, 4); PK_CE(x, 5, 6); PK_CE(x, 8, 9); PK_CE(x, 10, 11); PK_CE(x, 8, 10); PK_CE(x, 9, 11); PK_CE(x, 9, 10);
    PK_CE(x, 12, 13); PK_CE(x, 14, 15); PK_CE(x, 12, 14); PK_CE(x, 13, 15); PK_CE(x, 13, 14); PK_CE(x, 8, 12); PK_CE(x, 10, 14); PK_CE(x, 10, 12);
    PK_CE(x, 9, 13); PK_CE(x, 11, 15); PK_CE(x, 11, 13); PK_CE(x, 9, 10); PK_CE(x, 11, 12); PK_CE(x, 13, 14); PK_CE(x, 0, 8); PK_CE(x, 4, 12);
    PK_CE(x, 4, 8); PK_CE(x, 2, 10); PK_CE(x, 6, 14); PK_CE(x, 6, 10); PK_CE(x, 2, 4); PK_CE(x, 6, 8); PK_CE(x, 10, 12); PK_CE(x, 1, 9);
    PK_CE(x, 5, 13); PK_CE(x, 5, 9); PK_CE(x, 3, 11); PK_CE(x, 7, 15); PK_CE(x, 7, 11); PK_CE(x, 3, 5); PK_CE(x, 7, 9); PK_CE(x, 11, 13);
    PK_CE(x, 1, 2); PK_CE(x, 3, 4); PK_CE(x, 5, 6); PK_CE(x, 7, 8); PK_CE(x, 9, 10); PK_CE(x, 11, 12); PK_CE(x, 13, 14);
    __builtin_amdgcn_sched_barrier(0);
}
__device__ __forceinline__ void merge16_top(float (&a)[16], const float (&b)[16]) {
#pragma unroll
    for (int i = 0; i < 16; ++i) a[i] = __builtin_amdgcn_fmed3f(a[i], b[15 - i], __builtin_inff());
    PK_CE(a, 0, 8); PK_CE(a, 1, 9); PK_CE(a, 2, 10); PK_CE(a, 3, 11); PK_CE(a, 4, 12); PK_CE(a, 5, 13); PK_CE(a, 6, 14); PK_CE(a, 7, 15);
    PK_CE(a, 0, 4); PK_CE(a, 1, 5); PK_CE(a, 2, 6); PK_CE(a, 3, 7); PK_CE(a, 8, 12); PK_CE(a, 9, 13); PK_CE(a, 10, 14); PK_CE(a, 11, 15);
    PK_CE(a, 0, 2); PK_CE(a, 1, 3); PK_CE(a, 4, 6); PK_CE(a, 5, 7); PK_CE(a, 8, 10); PK_CE(a, 9, 11); PK_CE(a, 12, 14); PK_CE(a, 13, 15);
    PK_CE(a, 0, 1); PK_CE(a, 2, 3); PK_CE(a, 4, 5); PK_CE(a, 6, 7); PK_CE(a, 8, 9); PK_CE(a, 10, 11); PK_CE(a, 12, 13); PK_CE(a, 14, 15);
    __builtin_amdgcn_sched_barrier(0);
}
__device__ __forceinline__ void top16_insert_f(float (&l)[16], float k) {
    float n[16];
    n[0] = __builtin_amdgcn_fmed3f(l[0], k, __builtin_inff());
#pragma unroll
    for (int i = 1; i < 16; ++i) n[i] = __builtin_amdgcn_fmed3f(l[i - 1], l[i], k);
#pragma unroll
    for (int i = 0; i < 16; ++i) l[i] = n[i];
    __builtin_amdgcn_sched_barrier(0);
}
__device__ __forceinline__ void peer_topk_tail_f(const float (&l1)[16], const float (&l2)[16], int t0, int hd, int lane, int* ids, float* gates, LAS unsigned* tab) {
    float v1[16], v2[16];
#pragma unroll
    for (int i = 0; i < 16; ++i) { const unsigned b1 = __float_as_uint(l1[i]), b2 = __float_as_uint(l2[i]);
        v1[i] = __uint_as_float(b1 & 0xffffff80u); v2[i] = __uint_as_float(b2 & 0xffffff80u);
        tab[i * 64 + lane] = b1 & 127u; tab[(16 + i) * 64 + lane] = b2 & 127u; }
    float cl[16];
#pragma unroll
    for (int i = 0; i < 16; ++i) cl[i] = -__builtin_inff();
#pragma unroll
    for (int a = 0; a < 16; ++a)
#pragma unroll
        for (int b = 0; b < 16; ++b)
            if ((a + 1) * (b + 1) <= 16) top16_insert_f(cl, __uint_as_float((__float_as_uint(v1[a] + v2[b]) & 0xffffff00u) | (unsigned)(a * 16 + b)));
    float sc[16]; int e[16];
#pragma unroll
    for (int k = 0; k < 16; ++k) {
        const unsigned c = __float_as_uint(cl[k]);
        sc[k] = __uint_as_float(c & 0xffffff00u);
        const unsigned i1 = tab[((c >> 4) & 15u) * 64 + lane], i2 = tab[(16u + (c & 15u)) * 64 + lane];
        e[k] = (int)(i1 * 128u + i2);
    }
    float den = 0.f, g[16];
#pragma unroll
    for (int k = 0; k < 16; ++k) { g[k] = fast_exp(sc[k] - sc[0]); den += g[k]; }
    const float inv = fast_rcp(den);
    if (lane < 32) {
        int4* ip = (int4*)(ids + (size_t)(t0 + lane) * 128 + hd * 16);
        float4* gp = (float4*)(gates + (size_t)(t0 + lane) * 128 + hd * 16);
#pragma unroll
        for (int q = 0; q < 4; ++q) { ip[q] = make_int4(e[4 * q], e[4 * q + 1], e[4 * q + 2], e[4 * q + 3]);
            gp[q] = make_float4(g[4 * q] * inv, g[4 * q + 1] * inv, g[4 * q + 2] * inv, g[4 * q + 3] * inv); }
    }
}
constexpr int QT_PITCH = 528;
__device__ __forceinline__ void peer_half_top16_lds(LAS const unsigned char* qtile, const bf16_t* kp, int w, int hd, int half, int lane, float (&lst)[16]) {
    int h = lane >> 5; const int tl = lane & 31;
    asm volatile("" : "+v"(h));
    const unsigned h4 = 4u * (unsigned)h;
    f32x16 sT[4];
#pragma unroll
    for (int nt = 0; nt < 4; ++nt) sT[nt] = zero16();
    LAS const unsigned char* qb = qtile + (32 * w + tl) * QT_PITCH + (half * 128 + 8 * h) * 2;
    const bf16_t* kb = kp + ((size_t)(half * 8 + hd) * 128 + tl) * 128 + 8 * h;
#pragma unroll 2
    for (int ks = 0; ks < 8; ++ks) {
        const bf16x8 b = *(LAS const bf16x8*)(qb + 32 * ks);
#pragma unroll
        for (int nt = 0; nt < 4; ++nt) { const bf16x8 a = *(const bf16x8*)(kb + (size_t)nt * 32 * 128 + 16 * ks); sT[nt] = MFMA32(a, b, sT[nt]); }
    }
    float g1[16], g2[16];
#pragma unroll
    for (int r = 0; r < 16; ++r) { lst[r] = __uint_as_float(((__float_as_uint(sT[0][r]) & 0xffffff80u) | (unsigned)(ROWOFF(r))) | h4);
        g1[r] = __uint_as_float(((__float_as_uint(sT[1][r]) & 0xffffff80u) | (unsigned)(32 + ROWOFF(r))) | h4); }
    sort16_desc(lst); sort16_desc(g1); merge16_top(lst, g1);
#pragma unroll
    for (int r = 0; r < 16; ++r) { g1[r] = __uint_as_float(((__float_as_uint(sT[2][r]) & 0xffffff80u) | (unsigned)(64 + ROWOFF(r))) | h4);
        g2[r] = __uint_as_float(((__float_as_uint(sT[3][r]) & 0xffffff80u) | (unsigned)(96 + ROWOFF(r))) | h4); }
    sort16_desc(g1); sort16_desc(g2); merge16_top(g1, g2);
    merge16_top(lst, g1);
#pragma unroll
    for (int i = 0; i < 16; ++i) g1[i] = __shfl_xor(lst[i], 32);
    merge16_top(lst, g1);
}
struct EpiQrTopk {
    static constexpr bool PERM = true, AFTER_DRAIN = true;
    const float* rowss; const bf16_t* kp; int* ids; float* gates;
    __device__ __forceinline__ void operator()(const f32x4 (&)[2][2][4][2], const pg8::Unit&, int, int, int, int) const {}
    __device__ __forceinline__ void fused(const f32x4 (&acc)[2][2][4][2], const pg8::Unit& u, int wr, int wc, int fr, int fq, LAS unsigned char* lds, int wid, int lane) const {
        __builtin_amdgcn_sched_barrier(0); asm volatile("s_nop 15\n\ts_nop 15" ::: "memory"); __builtin_amdgcn_sched_barrier(0);
#pragma unroll
        for (int ai = 0; ai < 2; ++ai)
#pragma unroll
            for (int m = 0; m < 4; ++m) { const int rl = ai * 128 + wr * 64 + m * 16 + fr; const float rs = row_rstd(rowss, u.pm * 256 + rl) * (1.0f / (WG_SCALE * X8_SCALE));
#pragma unroll
                for (int bj = 0; bj < 2; ++bj) { const int cl = bj * 128 + wc * 32 + 8 * fq;
                    const f32x4 v0 = acc[ai][bj][m][0] * rs, v1 = acc[ai][bj][m][1] * rs;
                    *(LAS u32x4*)(lds + rl * QT_PITCH + cl * 2) = pack_acc(v0, v1); }
                __builtin_amdgcn_sched_barrier(0); }
        __syncthreads();
        float l1[16], l2[16];
        peer_half_top16_lds(lds, kp, wid, u.pn, 0, lane, l1);
        peer_half_top16_lds(lds, kp, wid, u.pn, 1, lane, l2);
        __builtin_amdgcn_wave_barrier();
        peer_topk_tail_f(l1, l2, u.pm * 256 + 32 * wid, u.pn, lane, ids, gates, (LAS unsigned*)(lds + (32 * wid) * QT_PITCH));
        __syncthreads();
    }
};
struct OneUnit {
    pg8::Unit u;
    __device__ __forceinline__ bool next(int i, pg8::Unit& o) const { if (i != 0) return false; o = u; return true; }
    __device__ __forceinline__ void a_ready(const pg8::Unit&) const {}
    __device__ __forceinline__ void done(const pg8::Unit&) const {}
};

__device__ __forceinline__ float dot16_fp4(const u32x2& w, const float (&x)[16]) {
    float s0 = 0.f, s1 = 0.f;
#pragma unroll
    for (int q = 0; q < 2; ++q) {
        const f32x2_t v0 = __builtin_amdgcn_cvt_scalef32_pk_f32_fp4(w[q], 1.0f, 0), v1 = __builtin_amdgcn_cvt_scalef32_pk_f32_fp4(w[q], 1.0f, 1);
        const f32x2_t v2 = __builtin_amdgcn_cvt_scalef32_pk_f32_fp4(w[q], 1.0f, 2), v3 = __builtin_amdgcn_cvt_scalef32_pk_f32_fp4(w[q], 1.0f, 3);
        s0 += v0[0] * x[8 * q] + v1[0] * x[8 * q + 2] + v2[0] * x[8 * q + 4] + v3[0] * x[8 * q + 6];
        s1 += v0[1] * x[8 * q + 1] + v1[1] * x[8 * q + 3] + v2[1] * x[8 * q + 5] + v3[1] * x[8 * q + 7];
    }
    return s0 + s1;
}
__device__ __forceinline__ void wave_sum8(float (&r)[8], const float (&d)[8]) {
    float a[4], b2[2];
#pragma unroll
    for (int k = 0; k < 4; ++k) { const auto s = __builtin_amdgcn_permlane32_swap(__float_as_uint(d[k]), __float_as_uint(d[k + 4]), false, false); a[k] = __uint_as_float(s[0]) + __uint_as_float(s[1]); }
#pragma unroll
    for (int k = 0; k < 2; ++k) { const auto s = __builtin_amdgcn_permlane16_swap(__float_as_uint(a[k]), __float_as_uint(a[k + 2]), false, false); b2[k] = __uint_as_float(s[0]) + __uint_as_float(s[1]); }
    float c0 = b2[0], c1 = b2[1];
    c0 += dpp_f<0xB1>(c0); c0 += dpp_f<0x4E>(c0); c0 += dpp_f<0x141>(c0); c0 += dpp_f<0x140>(c0);
    c1 += dpp_f<0xB1>(c1); c1 += dpp_f<0x4E>(c1); c1 += dpp_f<0x141>(c1); c1 += dpp_f<0x140>(c1);
    r[0] = __int_as_float(__builtin_amdgcn_readlane(__float_as_int(c0), 0));  r[1] = __int_as_float(__builtin_amdgcn_readlane(__float_as_int(c1), 0));
    r[2] = __int_as_float(__builtin_amdgcn_readlane(__float_as_int(c0), 16)); r[3] = __int_as_float(__builtin_amdgcn_readlane(__float_as_int(c1), 16));
    r[4] = __int_as_float(__builtin_amdgcn_readlane(__float_as_int(c0), 32)); r[5] = __int_as_float(__builtin_amdgcn_readlane(__float_as_int(c1), 32));
    r[6] = __int_as_float(__builtin_amdgcn_readlane(__float_as_int(c0), 48)); r[7] = __int_as_float(__builtin_amdgcn_readlane(__float_as_int(c1), 48));
}
__device__ __forceinline__ void axpy16_fp4(float (&o)[16], float a, const u32x2& w) {
#pragma unroll
    for (int q = 0; q < 2; ++q) {
        const f32x2_t v0 = __builtin_amdgcn_cvt_scalef32_pk_f32_fp4(w[q], 1.0f, 0), v1 = __builtin_amdgcn_cvt_scalef32_pk_f32_fp4(w[q], 1.0f, 1);
        const f32x2_t v2 = __builtin_amdgcn_cvt_scalef32_pk_f32_fp4(w[q], 1.0f, 2), v3 = __builtin_amdgcn_cvt_scalef32_pk_f32_fp4(w[q], 1.0f, 3);
        o[8 * q] += a * v0[0]; o[8 * q + 1] += a * v0[1]; o[8 * q + 2] += a * v1[0]; o[8 * q + 3] += a * v1[1];
        o[8 * q + 4] += a * v2[0]; o[8 * q + 5] += a * v2[1]; o[8 * q + 6] += a * v3[0]; o[8 * q + 7] += a * v3[1];
    }
}
typedef int i32x8 __attribute__((ext_vector_type(8)));
constexpr int PG_TOK = 8;
constexpr int PG_STG = 69632;
constexpr int PG_COEF = PG_TOK * 512, PG_WAVE = PG_COEF + 4096, PG_ZERO = 8 * PG_WAVE;
typedef int i32x4 __attribute__((ext_vector_type(4)));
__device__ __forceinline__ f32x4 pg_mfma(const u32x4& a, const i32x8& b, const f32x4& c) {
    const i32x4 a4 = __builtin_bit_cast(i32x4, a);
    return __builtin_amdgcn_mfma_scale_f32_16x16x128_f8f6f4(__builtin_shufflevector(a4, a4, 0, 1, 2, 3, -1, -1, -1, -1), b, c, 4, 0, 0, 0x7F7F7F7F, 0, 0x7F7F7F7F);
}
__device__ __forceinline__ void phase_peer_gather(const Params& p, LAS unsigned char* lds, int layer, int wv, int tfirst, int tstride, int tend) {
    const int tid = opaque_tid(wv), lane = tid & 63, wid = wv;
    const int r16 = lane & 15, g = lane >> 4;
    const int gw = tfirst + wid, nw = tstride;
    const unsigned char* U = p.ws + OFF_U + (size_t)layer * 16384 * 512; const unsigned char* V = p.ws + OFF_V + (size_t)layer * 16384 * 512;
    const int* ids = (const int*)(p.ws + OFF_PIDS); const float* gates = (const float*)(p.ws + OFF_PGT);
    const bf16_t* x1b = (const bf16_t*)(p.ws + OFF_H); bf16_t* xnew = (bf16_t*)(p.ws + OFF_XS); const float* rowss = (const float*)(p.ws + OFF_ROWSS);
    const float* g2 = p.norm2 + layer * DM;
    const float* gn = (layer + 1 < NLAYER) ? p.norm1 + (layer + 1) * DM : p.norm_f;
    LAS unsigned char* wl = lds + wid * PG_WAVE;
    { unsigned z0 = 0u; asm volatile("" : "+v"(z0));
      if (tid < 64) ((LAS u32x4*)(lds + PG_ZERO))[tid] = (u32x4){z0, z0, z0, z0}; }
    __syncthreads();
    LAS unsigned char* wh = wl + PG_COEF;
    LAS const unsigned char* bsrc = (r16 < 4 ? wh + 1024 * (r16 & 1) + 128 * (r16 >> 1) : lds + PG_ZERO) + 16 * g;
    LAS float* coef0 = (LAS float*)wl;
#define PG_LD(T_, base_, off_) (*(const T_*)((const unsigned char*)(base_) + (off_)))
#define PG_OFFS unsigned l64 = 64u * (unsigned)lane, l8 = 8u * (unsigned)lane, l4 = 4u * (unsigned)lane, g16 = 16u * (unsigned)g, r4 = 4u * (unsigned)r16; \
                asm volatile("" : "+v"(l64), "+v"(l8), "+v"(l4), "+v"(g16), "+v"(r4));
    for (int tc = gw; tc < tend; tc += PG_TOK * nw) {
        const int left = (tend - tc + nw - 1) / nw, nt = left < PG_TOK ? left : PG_TOK;
        {
            const int er = r16 >> 1;
            u32x4 P0[4], P1[4], P2[4], P3[4];
            f32x4 gq[4]; u32x4 xa[2]; float rs;
#define PG_ULOAD(P_, id_) do { const unsigned o_ = (unsigned)(id_) * 512u + hoff; _Pragma("unroll") for (int s = 0; s < 4; ++s) P_[s] = *(const u32x4*)(U + o_ + 128 * s); } while (0)
            {   PG_OFFS
                const unsigned hoff = 64u * (unsigned)(r16 & 1) + g16, e4 = 4u * (unsigned)er;
                const int* idp = ids + (size_t)tc * 128;
                const int i0 = PG_LD(int, idp, e4), i1 = PG_LD(int, idp + 8, e4), i2 = PG_LD(int, idp + 16, e4), i3 = PG_LD(int, idp + 24, e4);
                PG_ULOAD(P0, i0); PG_ULOAD(P1, i1); PG_ULOAD(P2, i2); PG_ULOAD(P3, i3);
#pragma unroll
                for (int q = 0; q < 4; ++q) gq[q] = PG_LD(f32x4, g2 + 4 * q, l64);
                xa[0] = PG_LD(u32x4, x1b + (size_t)tc * DM, l64 >> 1); xa[1] = PG_LD(u32x4, x1b + (size_t)tc * DM + 8, l64 >> 1);
                rs = row_rstd(rowss, tc);
            }
#pragma unroll 1
            for (int i = 0; i < nt; ++i) {
                const int t = tc + i * nw, tn = i + 1 < nt ? t + nw : t;
                PG_OFFS
                unsigned hoff = 64u * (unsigned)(r16 & 1) + g16, e4 = 4u * (unsigned)er, g8 = 8u * (unsigned)g;
                asm volatile("" : "+v"(hoff), "+v"(e4), "+v"(g8));
                const int* idp = ids + (size_t)t * 128; const int* idn = ids + (size_t)tn * 128;
                int raw[16];
#pragma unroll
                for (int b = 0; b < 12; ++b) raw[b] = PG_LD(int, idp + 8 * (b + 4), e4);
#pragma unroll
                for (int b = 0; b < 4; ++b) raw[12 + b] = PG_LD(int, idn + 8 * b, e4);
                {
                    u32x4 hw, lw;
#pragma unroll
                    for (int q = 0; q < 4; ++q) { const unsigned wa = xa[q >> 1][2 * (q & 1)], wb = xa[q >> 1][2 * (q & 1) + 1]; const f32x4 a = {bf_lo(wa), bf_hi(wa), bf_lo(wb), bf_hi(wb)}, gg = gq[q];
                        const float h0 = a[0] * gg[0] * rs, h1 = a[1] * gg[1] * rs, h2 = a[2] * gg[2] * rs, h3 = a[3] * gg[3] * rs;
                        int w = 0; w = __builtin_amdgcn_cvt_pk_fp8_f32(h0, h1, w, false); w = __builtin_amdgcn_cvt_pk_fp8_f32(h2, h3, w, true);
                        const float d0 = (h0 - __builtin_amdgcn_cvt_f32_fp8(w, 0)) * 64.0f, d1 = (h1 - __builtin_amdgcn_cvt_f32_fp8(w, 1)) * 64.0f;
                        const float d2 = (h2 - __builtin_amdgcn_cvt_f32_fp8(w, 2)) * 64.0f, d3 = (h3 - __builtin_amdgcn_cvt_f32_fp8(w, 3)) * 64.0f;
                        int v = 0; v = __builtin_amdgcn_cvt_pk_fp8_f32(d0, d1, v, false); v = __builtin_amdgcn_cvt_pk_fp8_f32(d2, d3, v, true);
                        hw[q] = (unsigned)w; lw[q] = (unsigned)v; }
                    *(LAS u32x4*)(wh + 16 * lane) = hw; *(LAS u32x4*)(wh + 1024 + 16 * lane) = lw;
                    xa[0] = PG_LD(u32x4, x1b + (size_t)tn * DM, l64 >> 1); xa[1] = PG_LD(u32x4, x1b + (size_t)tn * DM + 8, l64 >> 1);
                    rs = row_rstd(rowss, tn);
                }
                __builtin_amdgcn_wave_barrier();
                i32x8 B[4];
#pragma unroll
                for (int s = 0; s < 4; ++s) { const u32x4 b0 = *(LAS const u32x4*)(bsrc + 256 * s), b1 = *(LAS const u32x4*)(bsrc + 256 * s + 64);
                    B[s] = (i32x8){(int)b0[0], (int)b0[1], (int)b0[2], (int)b0[3], (int)b1[0], (int)b1[1], (int)b1[2], (int)b1[3]}; }
                __builtin_amdgcn_sched_barrier(0);
                LAS float* coef = coef0 + i * 128;
                const float sc = (r16 & 1) ? (1.0f / (64.0f * U4_SCALE)) : (1.0f / U4_SCALE);
                const bool first = r16 < 2;
#define PG_UBLOCK(P_, b_) do { \
                    const f32x2_t gt_ = PG_LD(f32x2_t, gates + (size_t)t * 128 + 8 * (b_), g8); \
                    f32x4 acc_ = {0.f, 0.f, 0.f, 0.f}; \
                    _Pragma("unroll") for (int s = 0; s < 4; ++s) acc_ = pg_mfma(P_[s], B[s], acc_); \
                    PG_ULOAD(P_, raw[(b_) - 0]); \
                    float va_ = (first ? acc_[0] : acc_[1]) * sc, vb_ = (first ? acc_[2] : acc_[3]) * sc; \
                    va_ += dpp_f<0xB1>(va_); vb_ += dpp_f<0xB1>(vb_); va_ += dpp_f<0x4E>(va_); vb_ += dpp_f<0x4E>(vb_); \
                    f32x2_t cf_ = {gelu_tanh(va_) * gt_[0], gelu_tanh(vb_) * gt_[1]}; \
                    asm volatile("" : "+v"(cf_)); \
                    if (r16 == 0) *(LAS f32x2_t*)(coef + 8 * (b_) + 2 * g) = cf_; \
                    __builtin_amdgcn_sched_barrier(0); } while (0)
                PG_UBLOCK(P0, 0); PG_UBLOCK(P1, 1); PG_UBLOCK(P2, 2); PG_UBLOCK(P3, 3);
                PG_UBLOCK(P0, 4); PG_UBLOCK(P1, 5); PG_UBLOCK(P2, 6); PG_UBLOCK(P3, 7);
                PG_UBLOCK(P0, 8); PG_UBLOCK(P1, 9); PG_UBLOCK(P2, 10); PG_UBLOCK(P3, 11);
                PG_UBLOCK(P0, 12); PG_UBLOCK(P1, 13); PG_UBLOCK(P2, 14); PG_UBLOCK(P3, 15);
            }
        }
        __builtin_amdgcn_wave_barrier();
        {
            int idA, idB;
            u32x2 vr0[8], vr1[8];
#define PG_VBATCH(vr_, b_) do { const f32x4 c0_ = *(LAS const f32x4*)(coef + 8 * (b_)), c1_ = *(LAS const f32x4*)(coef + 8 * (b_) + 4); \
            _Pragma("unroll") for (int k = 0; k < 8; ++k) { axpy16_fp4(o, k < 4 ? c0_[k & 3] : c1_[k & 3], vr_[k]); __builtin_amdgcn_sched_barrier(0); } } while (0)
#define PG_VLOAD(vr_, ida_, idb_, b_) do { const int idr_ = (b_) < 8 ? ida_ : idb_; const int l_ = (8 * (b_)) & 63; \
            _Pragma("unroll") for (int k = 0; k < 8; ++k) { const int e = __builtin_amdgcn_readlane(idr_, l_ + k); vr_[k] = PG_LD(u32x2, V + (size_t)(unsigned)e * 512u, l8); } \
            __builtin_amdgcn_sched_barrier(0); } while (0)
            {   PG_OFFS
                const int* idp = ids + (size_t)tc * 128;
                idA = PG_LD(int, idp, l4); idB = PG_LD(int, idp + 64, l4);
                PG_VLOAD(vr0, idA, idB, 0); PG_VLOAD(vr1, idA, idB, 1);
            }
#pragma unroll 1
            for (int i = 0; i < nt; ++i) {
                const int t = tc + i * nw, tn = i + 1 < nt ? t + nw : t;
                PG_OFFS
                const bf16_t* xr = x1b + (size_t)t * DM;
                const int* idn = ids + (size_t)tn * 128;
                const int nidA = PG_LD(int, idn, l4), nidB = PG_LD(int, idn + 64, l4);
                LAS const float* coef = coef0 + i * 128;
                if (layer + 1 < NLAYER) {
                    const bool isv = t >= 8192; const int tt = isv ? t - 8192 : t;
                    const unsigned char* cs = (const unsigned char*)((isv ? p.peer_v : p.peer_u) + (size_t)(layer + 1) * 16384 * 1024 + (size_t)tt * 2048);
#pragma unroll
                    for (int j = 0; j < 8; ++j) __builtin_amdgcn_global_load_lds((const unsigned*)(cs + 1024 * j + (l64 >> 2)), (LAS unsigned*)(lds + PG_STG + wid * 8192 + 1024 * j), 16, 0, 2);
                }
                float o[16];
#pragma unroll
                for (int k = 0; k < 16; ++k) o[k] = 0.f;
#pragma unroll 1
                for (int bb = 0; bb < 7; ++bb) {
                    PG_VBATCH(vr0, 2 * bb); PG_VLOAD(vr0, idA, idB, 2 * bb + 2);
                    PG_VBATCH(vr1, 2 * bb + 1); PG_VLOAD(vr1, idA, idB, 2 * bb + 3);
                }
                float x[16];
#pragma unroll
                for (int q = 0; q < 2; ++q) { const u32x4 a = PG_LD(u32x4, xr + 8 * q, l64 >> 1);
#pragma unroll
                    for (int e = 0; e < 4; ++e) { x[8 * q + 2 * e] = bf_lo(a[e]); x[8 * q + 2 * e + 1] = bf_hi(a[e]); } }
                __builtin_amdgcn_sched_barrier(0);
                PG_VBATCH(vr0, 14); PG_VLOAD(vr0, nidA, nidB, 0);
                PG_VBATCH(vr1, 15); PG_VLOAD(vr1, nidA, nidB, 1);
                idA = nidA; idB = nidB;
                float ss = 0.f;
#pragma unroll
                for (int k = 0; k < 16; ++k) { x[k] += o[k] * (1.0f / V4_SCALE); ss += x[k] * x[k]; }
                ss = wave_sum(ss);
                const float rn = rsqrtf(ss * (1.0f / DM) + RMS_EPS);
                float nx[16];
#pragma unroll
                for (int q = 0; q < 4; ++q) { const f32x4 gg = PG_LD(f32x4, gn + 4 * q, l64);
#pragma unroll
                    for (int e = 0; e < 4; ++e) nx[4 * q + e] = x[4 * q + e] * rn * gg[e]; }
#define PG_ROW_BF16(dst_, v_) do { u32x4 w0_, w1_; \
                    w0_.x = cvt_pk_bf16(v_[0], v_[1]); w0_.y = cvt_pk_bf16(v_[2], v_[3]); w0_.z = cvt_pk_bf16(v_[4], v_[5]); w0_.w = cvt_pk_bf16(v_[6], v_[7]); \
                    w1_.x = cvt_pk_bf16(v_[8], v_[9]); w1_.y = cvt_pk_bf16(v_[10], v_[11]); w1_.z = cvt_pk_bf16(v_[12], v_[13]); w1_.w = cvt_pk_bf16(v_[14], v_[15]); \
                    *(LAS u32x4*)(wh + 32 * lane) = w0_; *(LAS u32x4*)(wh + 32 * lane + 16) = w1_; \
                    __builtin_amdgcn_wave_barrier(); \
                    _Pragma("unroll") for (int j = 0; j < 2; ++j) { const u32x4 r_ = *(LAS const u32x4*)(wh + 16 * lane + 1024 * j); *(u32x4*)((unsigned char*)(dst_) + (l64 >> 2) + 1024 * j) = r_; } \
                    __builtin_amdgcn_wave_barrier(); } while (0)
                if (layer + 1 < NLAYER) {
                    PG_ROW_BF16(xnew + (size_t)t * DM, x);
                    PG_ROW_BF16((bf16_t*)(p.ws + OFF_H) + (size_t)t * DM, nx);
                    { u32x4 o8;
#pragma unroll
                      for (int i = 0; i < 4; ++i) { unsigned a = 0u; a = __builtin_amdgcn_cvt_pk_fp8_f32(nx[4 * i], nx[4 * i + 1], a, false); a = __builtin_amdgcn_cvt_pk_fp8_f32(nx[4 * i + 2], nx[4 * i + 3], a, true); o8[i] = a; }
                      *(u32x4*)(p.ws + OFF_H8 + (size_t)t * DM + (l64 >> 2)) = o8; }
                    {
                        asm volatile("s_waitcnt vmcnt(40)" ::: "memory");
                        const bool isv = t >= 8192; const int tt = isv ? t - 8192 : t;
                        unsigned char* cd = p.ws + (isv ? OFF_V : OFF_U) + (size_t)(layer + 1) * 16384 * 512 + (size_t)tt * 1024;
                        const float cscale = isv ? V4_SCALE : U4_SCALE;
                        unsigned lo_ = (unsigned)(lane >> 5) * 4096u + (unsigned)(lane & 31) * 32u, go_ = (unsigned)(lane >> 5) * 512u + (unsigned)(lane & 31) * 4u;
                        asm volatile("" : "+v"(lo_), "+v"(go_));
                        LAS const unsigned char* sg = lds + PG_STG + wid * 8192;
#pragma unroll 1
                        for (int jj = 0; jj < 4; ++jj) {
                            f32x4 a = *(LAS const f32x4*)(sg + lo_ + 1024 * jj), b = *(LAS const f32x4*)(sg + lo_ + 1024 * jj + 16);
#pragma unroll
                            for (int e = 0; e < 4; ++e) { a[e] = fminf(fmaxf(a[e] * cscale, -6.0f), 6.0f); b[e] = fminf(fmaxf(b[e] * cscale, -6.0f), 6.0f); }
                            unsigned pk = 0u;
                            pk = __builtin_amdgcn_cvt_scalef32_pk_fp4_f32(pk, a[0], a[1], 1.0f, 0);
                            pk = __builtin_amdgcn_cvt_scalef32_pk_fp4_f32(pk, a[2], a[3], 1.0f, 1);
                            pk = __builtin_amdgcn_cvt_scalef32_pk_fp4_f32(pk, b[0], b[1], 1.0f, 2);
                            pk = __builtin_amdgcn_cvt_scalef32_pk_fp4_f32(pk, b[2], b[3], 1.0f, 3);
                            __builtin_nontemporal_store(pk, (unsigned*)(cd + 128 * jj + go_));
                        }
                    }
                } else {
#pragma unroll
                    for (int q = 0; q < 4; ++q) *(LAS f32x4*)(wh + 64 * lane + 16 * q) = (f32x4){nx[4 * q], nx[4 * q + 1], nx[4 * q + 2], nx[4 * q + 3]};
                    __builtin_amdgcn_wave_barrier();
#pragma unroll
                    for (int j = 0; j < 4; ++j) { const f32x4 r = *(LAS const f32x4*)(wh + 16 * lane + 1024 * j); *(f32x4*)((unsigned char*)(p.out + (size_t)t * DM) + (l64 >> 2) + 1024 * j) = r; }
                    __builtin_amdgcn_wave_barrier();
                }
            }
        }
        __builtin_amdgcn_wave_barrier();
#ifdef PROBE_MASK
        {
            int idA, idB;
            u32x2 vr0[8], vr1[8];
#define PG_VLOADM(vr_, ida_, idb_, b_) do { const int idr_ = (b_) < 8 ? ida_ : idb_; const int l_ = (8 * (b_)) & 63; \
            _Pragma("unroll") for (int k = 0; k < 8; ++k) { const int e = __builtin_amdgcn_readlane(idr_, l_ + k) & PROBE_MASK; vr_[k] = PG_LD(u32x2, V + (size_t)(unsigned)e * 512u, l8); } \
            __builtin_amdgcn_sched_barrier(0); } while (0)
            {   PG_OFFS
                const int* idp = ids + (size_t)tc * 128;
                idA = PG_LD(int, idp, l4); idB = PG_LD(int, idp + 64, l4);
                PG_VLOADM(vr0, idA, idB, 0); PG_VLOADM(vr1, idA, idB, 1);
            }
#pragma unroll 1
            for (int i = 0; i < nt; ++i) {
                const int t = tc + i * nw, tn = i + 1 < nt ? t + nw : t;
                PG_OFFS
                const int* idn = ids + (size_t)tn * 128;
                const int nidA = PG_LD(int, idn, l4), nidB = PG_LD(int, idn + 64, l4);
                LAS const float* coef = coef0 + i * 128;
                float o[16];
#pragma unroll
                for (int k = 0; k < 16; ++k) o[k] = 0.f;
#pragma unroll 1
                for (int bb = 0; bb < 7; ++bb) {
                    PG_VBATCH(vr0, 2 * bb); PG_VLOADM(vr0, idA, idB, 2 * bb + 2);
                    PG_VBATCH(vr1, 2 * bb + 1); PG_VLOADM(vr1, idA, idB, 2 * bb + 3);
                }
                PG_VBATCH(vr0, 14); PG_VLOADM(vr0, nidA, nidB, 0);
                PG_VBATCH(vr1, 15); PG_VLOADM(vr1, nidA, nidB, 1);
                idA = nidA; idB = nidB;
                float* dump = (float*)((unsigned char*)((float*)(p.ws + OFF_QALL) + (size_t)t * DM) + l64);
#pragma unroll
                for (int q = 0; q < 4; ++q) *(f32x4*)(dump + 4 * q) = (f32x4){o[4 * q], o[4 * q + 1], o[4 * q + 2], o[4 * q + 3]};
            }
        }
        __builtin_amdgcn_wave_barrier();
#endif
    }
}

#define GAS __attribute__((address_space(1)))
struct ParamsG {
    const float GAS* x; const float GAS* norm1; const float GAS* w_in; const float GAS* sinks; const float GAS* cmp_pos; const float GAS* cmp_w1;
    const float GAS* cmp_w2; const float GAS* w_branch; const float GAS* w_out; const float GAS* norm2; const float GAS* peer_wq;
    const float GAS* peer_keys; const float GAS* peer_u; const float GAS* peer_v; const float GAS* norm_f;
    float GAS* out; unsigned char GAS* ws;
};
struct KP { Params v; __device__ __forceinline__ const Params& operator*() const { return v; } };
__device__ __forceinline__ KP kparams() {
    typedef const ParamsG __attribute__((address_space(4))) * KargPtr;
    KargPtr g = (KargPtr)__builtin_amdgcn_kernarg_segment_ptr(); asm volatile("" : "+s"(g));
    KP k;
    k.v.x = (const float*)g->x; k.v.norm1 = (const float*)g->norm1; k.v.w_in = (const float*)g->w_in; k.v.sinks = (const float*)g->sinks; k.v.cmp_pos = (const float*)g->cmp_pos;
    k.v.cmp_w1 = (const float*)g->cmp_w1; k.v.cmp_w2 = (const float*)g->cmp_w2; k.v.w_branch = (const float*)g->w_branch; k.v.w_out = (const float*)g->w_out; k.v.norm2 = (const float*)g->norm2;
    k.v.peer_wq = (const float*)g->peer_wq; k.v.peer_keys = (const float*)g->peer_keys; k.v.peer_u = (const float*)g->peer_u; k.v.peer_v = (const float*)g->peer_v; k.v.norm_f = (const float*)g->norm_f;
    k.v.out = (float*)g->out; k.v.ws = (unsigned char*)g->ws;
    return k;
}
#define PH_BEGIN const KP kp_ = kparams(); const Params& q = kp_.v; unsigned char* ws = q.ws; unsigned char* wl = ws + OFF_W + (size_t)layer * LW; const int G = gridDim.x, c = opaque_bid(); (void)wl; (void)G; (void)c;

struct TeamBranch {
    int pm, pn;
    __device__ __forceinline__ bool next(int i, pg8::Unit& u) const { if (i >= 3) return false; u.pm = pm + 64 * i; u.pn = pn + 4 * i; return true; }
    __device__ __forceinline__ void a_ready(const pg8::Unit&) const {}
    __device__ __forceinline__ void done(const pg8::Unit&) const {}
};
__device__ __forceinline__ void team_barrier(unsigned* ctr, unsigned target, unsigned* bar) {
    asm volatile("s_waitcnt vmcnt(0)" ::: "memory");
    __syncthreads();
    if (threadIdx.x == 0) { (void)xb_add(ctr, 1u); XB_SPIN(xb_ld(ctr) < target, bar); }
    __syncthreads();
}
template <int layer> __device__ __forceinline__ void layer_body(LAS unsigned char* lds, const int wv, const XcdBarrier& xb) {
        { PH_BEGIN
            pg8::Gemm g{(const bf16_t*)(ws + OFF_H), (const bf16_t*)(wl + W_IN), S_LEN, 2816, 1024}; pg8::StaticOrder S; S.init(S_LEN, 2816, G, c);
            EpiIn E{(bf16_t*)(ws + OFF_QALL), (bf16_t*)(ws + OFF_KALL), (bf16_t*)(ws + OFF_R)};
            pg8::gemm_phase<EpiIn, pg8::StaticOrder, true, true>(lds, g, S, E, wv);
        }
#define GATE_GEMM(Gv_, cv_, lim_) do { pg8::Gemm g{(const bf16_t*)(ws + OFF_H8), (const bf16_t*)(ws + OFF_WG8 + (size_t)layer * 3072 * 1024), S_LEN, 3072, 512}; \
            pg8::StaticOrder S; S.init(S_LEN, 3072, (Gv_), (cv_)); S.lim = (lim_); EpiGate E{ws + OFF_G8}; \
            pg8::gemm_phase<EpiGate, pg8::StaticOrder, true, true, true>(lds, g, S, E, wv); } while (0)
#define VT_GEMM(Gv_, cv_, lim_) do { pg8::Gemm g{(const bf16_t*)(wl + W_VT), (const bf16_t*)(ws + OFF_H), NVT, S_LEN, 1024}; \
            pg8::StaticOrder S; S.init(NVT, S_LEN, (Gv_), (cv_)); S.lim = (lim_); EpiVT E{(bf16_t*)(ws + OFF_VALL)}; \
            pg8::gemm_phase<EpiVT, pg8::StaticOrder, true, true>(lds, g, S, E, wv); } while (0)
        { PH_BEGIN
            const bool lightwg = (G == 256) && c >= 192;
            VT_GEMM(64, lightwg ? c - 192 : 0, lightwg ? 64 : 0);
        }
        xcd_barrier(xb);
        { PH_BEGIN phase2_compress(q, layer, lds, wv); }
        __syncthreads();
        { PH_BEGIN
            int gv = G, cv = c, lim = 256;
            if (G == 256) { if (c < 128) { gv = 128; cv = 64 + c; lim = 192; } else { gv = 64; cv = 192 + (c - 128); lim = c < 192 ? 256 : 0; } }
            VT_GEMM(gv, cv, lim);
        }
        { PH_BEGIN
            int gv = G, cv = c, lim = 768;
            if (G == 256) { if (c < 128) { gv = 128; lim = 256; } else if (c < 192) { gv = 64; cv = 256 + (c - 128); lim = 448; } else { gv = 64; cv = 448 + (c - 192); } }
            GATE_GEMM(gv, cv, lim);
        }
#undef GATE_GEMM
#undef VT_GEMM
        if (layer == 0) {
            __syncthreads();
            { PH_BEGIN conv_jobs<true>(q, lds, opaque_tid(wv), TJ_IN + TJ_VT, TJ_IN + TJ_VT + 3 * TJ_BR + TJ_OUT + TJ_Q, (unsigned*)(ws + OFF_BAR) + 96); }
        }
        xcd_barrier(xb);
        {
#define TEAM_INFO const unsigned tw_ = (unsigned)__builtin_amdgcn_readfirstlane((int)((volatile LAS unsigned*)(lds + XB_LDS_OFF))[2]); \
            const int T8 = (int)(tw_ & 0xffffu), j8 = (int)((tw_ >> 16) & 7u), NT8 = (int)gridDim.x >> 3, mb = j8 & 3; (void)mb; (void)NT8;
#define TEAM_ROWTILE(pr_) (j8 < 4 ? (pr_) : 63 - (pr_))
#define TEAM_SYNC(k_) do { TEAM_INFO if ((tw_ >> 19) & 1u) { unsigned char* wsb_ = kparams().v.ws; team_barrier((unsigned*)(wsb_ + OFF_TEAM) + T8 * 16, 8u * (unsigned)(layer * 4 + (k_) + 1), (unsigned*)(wsb_ + OFF_BAR)); } else xcd_barrier(xb); } while (0)
            { PH_BEGIN TEAM_INFO phase3(q, layer, lds, wv, T8, j8, NT8); }
            { PH_BEGIN TEAM_INFO __syncthreads(); phase2_attn(q, layer, lds, wv, T8, j8, NT8); }
            TEAM_SYNC(0);
            { PH_BEGIN TEAM_INFO
              pg8::Gemm g{(const bf16_t*)(ws + OFF_OA), (const bf16_t*)(wl + W_BR), 3 * S_LEN, 3 * 1024, 512};
              EpiMix3 E{(const unsigned char*)(ws + OFF_G8), (bf16_t*)(ws + OFF_QALL)};
#pragma unroll 1
              for (int pr = T8; pr < 32; pr += NT8) { TeamBranch S{TEAM_ROWTILE(pr), mb}; pg8::gemm_phase<EpiMix3, TeamBranch, true, true>(lds, g, S, E, wv); } }
            TEAM_SYNC(1);
            { PH_BEGIN TEAM_INFO
              pg8::Gemm g{(const bf16_t*)(ws + OFF_QALL), (const bf16_t*)(wl + W_OUT), S_LEN, 1024, 1024};
              EpiOut<(layer != 0)> E{layer == 0 ? (const void*)q.x : (const void*)(ws + OFF_XS), (bf16_t*)(ws + OFF_H), (float*)(ws + OFF_ROWSS), ws + OFF_H8};
#pragma unroll 1
              for (int pr = T8; pr < 32; pr += NT8) { OneUnit O; O.u.pm = TEAM_ROWTILE(pr); O.u.pn = mb; pg8::gemm_phase<EpiOut<(layer != 0)>, OneUnit, true, true>(lds, g, O, E, wv); } }
            TEAM_SYNC(2);
            { PH_BEGIN TEAM_INFO
              pg8::Gemm g{(const bf16_t*)(ws + OFF_H8), (const bf16_t*)(ws + OFF_WQ8 + (size_t)layer * 2048 * 1024), S_LEN, 2048, 512};
              EpiQrTopk E{(const float*)(ws + OFF_ROWSS), (const bf16_t*)(wl + W_KP), (int*)(ws + OFF_PIDS), (float*)(ws + OFF_PGT)};
#pragma unroll 1
              for (int pr = T8; pr < 32; pr += NT8)
#pragma unroll 1
                  for (int j = 0; j < 2; ++j) { OneUnit O; O.u.pm = TEAM_ROWTILE(pr); O.u.pn = 2 * mb + j; pg8::gemm_phase<EpiQrTopk, OneUnit, true, true, true>(lds, g, O, E, wv); } }
            TEAM_SYNC(3);
            { PH_BEGIN TEAM_INFO
#pragma unroll 1
              for (int pr = T8; pr < 32; pr += NT8) { const int tb_ = 256 * TEAM_ROWTILE(pr) + 64 * mb; phase_peer_gather(q, lds, layer, wv, tb_, 8, tb_ + 64); } }
#undef TEAM_SYNC
#undef TEAM_INFO
#undef TEAM_ROWTILE
        }
        if (layer + 1 < NLAYER) {
            __syncthreads();
            { PH_BEGIN conv_jobs<true>(q, lds, opaque_tid(wv), (layer + 1) * TJ_LAYER, (layer + 2) * TJ_LAYER, (unsigned*)(ws + OFF_BAR) + 64 + 16 * layer); }
            xcd_barrier(xb);
        }
}

__global__ void __launch_bounds__(NTHREADS, 2) mega(Params p_unused) {
    extern __shared__ __attribute__((aligned(16))) unsigned char lds_raw[];
    LAS unsigned char* lds = (LAS unsigned char*)lds_raw;
    const int wv = __builtin_amdgcn_readfirstlane((int)(threadIdx.x >> 6));
    if (threadIdx.x < 4) ((LAS unsigned*)(lds + XB_LDS_OFF))[threadIdx.x] = 0u;
    __syncthreads();
    XcdBarrier xb;
    { const KP kp_ = kparams(); const Params& q = kp_.v; xb = xcd_barrier_post((unsigned*)(q.ws + OFF_BAR), (volatile LAS unsigned*)(lds + XB_LDS_OFF)); }
    if (threadIdx.x == 0) { const KP kp_ = kparams(); ((volatile LAS unsigned*)(lds + XB_LDS_OFF))[3] = xb_add((unsigned*)(kp_.v.ws + OFF_RANK) + 16 * xb.x, 1u); }
    { const KP kp_ = kparams(); phase_prologue(kp_.v, lds, wv); }
    xcd_barrier(xb);
    {
        const KP kp_ = kparams(); unsigned* bar = (unsigned*)(kp_.v.ws + OFF_BAR);
        const unsigned G_ = gridDim.x, bid_ = blockIdx.x;
        unsigned good = (G_ == 256u) ? 1u : 0u;
#pragma unroll
        for (unsigned j = 0; j < 16; ++j) { const unsigned cj = xb_ld(&bar[XB_XCNT(j)]); good &= (cj == (j < 8 ? 32u : 0u)) ? 1u : 0u; }
        const unsigned rank = ((volatile LAS unsigned*)(lds + XB_LDS_OFF))[3];
        const unsigned T = good ? xb.x * 4u + (rank >> 3) : (bid_ >> 3), mbr = good ? (rank & 7u) : (bid_ & 7u);
        __syncthreads();
        if (threadIdx.x == 0) ((volatile LAS unsigned*)(lds + XB_LDS_OFF))[2] = T | (mbr << 16) | (good << 19);
    }
    __syncthreads();
    layer_body<0>(lds, wv, xb);
    layer_body<1>(lds, wv, xb);
}

extern "C" void kernel_launch(void* const* d_in, const int* in_sizes, int n_in, void* d_out, int out_size, void* d_ws, size_t ws_size,
                              hipStream_t stream) {
    static int grid_blocks = 0;
    if (grid_blocks == 0) {
        int dev = 0, cus = 0, per_cu = 0;
        if (hipGetDevice(&dev) != hipSuccess || hipDeviceGetAttribute(&cus, hipDeviceAttributeMultiprocessorCount, dev) != hipSuccess) { fprintf(stderr, "device query failed\n"); grid_blocks = -1; return; }
        if (hipFuncSetAttribute((const void*)mega, hipFuncAttributeMaxDynamicSharedMemorySize, LDS_BYTES) != hipSuccess) { fprintf(stderr, "hipFuncSetAttribute failed\n"); grid_blocks = -1; return; }
        if (hipOccupancyMaxActiveBlocksPerMultiprocessor(&per_cu, (const void*)mega, NTHREADS, LDS_BYTES) != hipSuccess || per_cu < 1) { fprintf(stderr, "occupancy query failed (%d)\n", per_cu); grid_blocks = -1; return; }
        if (ws_size < WS_END) { fprintf(stderr, "workspace too small: %zu < %zu\n", ws_size, (size_t)WS_END); grid_blocks = -1; return; }
        grid_blocks = cus & ~7;
        if (grid_blocks < 8 || grid_blocks > 512) { fprintf(stderr, "unsupported CU count %d\n", cus); grid_blocks = -1; return; }
    }
    if (grid_blocks < 0) return;
    if (hipMemsetAsync((char*)d_ws + OFF_BAR, 0, 32768, stream) != hipSuccess) { fprintf(stderr, "memset failed\n"); return; }
    Params p{};
    p.x = (const float*)d_in[0]; p.norm1 = (const float*)d_in[1]; p.w_in = (const float*)d_in[2]; p.sinks = (const float*)d_in[3];
    p.cmp_pos = (const float*)d_in[4]; p.cmp_w1 = (const float*)d_in[5]; p.cmp_w2 = (const float*)d_in[6]; p.w_branch = (const float*)d_in[7];
    p.w_out = (const float*)d_in[8]; p.norm2 = (const float*)d_in[9]; p.peer_wq = (const float*)d_in[10]; p.peer_keys = (const float*)d_in[11];
    p.peer_u = (const float*)d_in[12]; p.peer_v = (const float*)d_in[13]; p.norm_f = (const float*)d_in[14];
    p.out = (float*)d_out; p.ws = (unsigned char*)d_ws;
    void* args[] = {&p};
    hipError_t e = hipLaunchCooperativeKernel((const void*)mega, dim3(grid_blocks), dim3(NTHREADS), args, LDS_BYTES, stream);
    if (e != hipSuccess) fprintf(stderr, "cooperative launch failed: %s (grid %d)\n", hipGetErrorString(e), grid_blocks);
}
```
